# Optimizing an MI355X kernel written in HIP

```python
import math
import jax, jax.numpy as jnp
from jax import lax
import numpy as np

D_MODEL = 1024
BATCH = 8
SEQ = 4096
DEPTH = 2

N_META = 16
Q_BLOCK = 128
ROPE_THETA = 500000.0
RMS_EPS = 1e-6

MLA_HEADS = 8
MLA_NOPE = 64
MLA_ROPE = 32
MLA_V = 64
MLA_Q_RANK = 384
MLA_KV_RANK = 256

DIFF_HEADS = 4
DIFF_DH = 64
DIFF_ROPE = DIFF_DH // 4

D_FF = -(-(8 * D_MODEL) // (3 * 256)) * 256

COL_Q_LAT = MLA_Q_RANK
COL_KV_LAT = MLA_KV_RANK
COL_K_ROPE = MLA_ROPE
COL_DIFF_Q = DIFF_HEADS * 2 * DIFF_DH
COL_DIFF_K = DIFF_HEADS * 2 * DIFF_DH
COL_DIFF_V = DIFF_HEADS * 2 * DIFF_DH
COL_GATE_A = D_MODEL
COL_GATE_B = D_MODEL
IN_COLS = COL_Q_LAT + COL_KV_LAT + COL_K_ROPE + COL_DIFF_Q + COL_DIFF_K + COL_DIFF_V + COL_GATE_A + COL_GATE_B
SPLIT_POINTS = (
    COL_Q_LAT,
    COL_Q_LAT + COL_KV_LAT,
    COL_Q_LAT + COL_KV_LAT + COL_K_ROPE,
    COL_Q_LAT + COL_KV_LAT + COL_K_ROPE + COL_DIFF_Q,
    COL_Q_LAT + COL_KV_LAT + COL_K_ROPE + COL_DIFF_Q + COL_DIFF_K,
    COL_Q_LAT + COL_KV_LAT + COL_K_ROPE + COL_DIFF_Q + COL_DIFF_K + COL_DIFF_V,
    COL_Q_LAT + COL_KV_LAT + COL_K_ROPE + COL_DIFF_Q + COL_DIFF_K + COL_DIFF_V + COL_GATE_A,
)

kernel_name = "hybrid_mla_diffattn_gated_block"


def rms_norm(x, gain):
    xf = x.astype(jnp.float32)
    y = xf * lax.rsqrt(jnp.mean(xf * xf, axis=-1, keepdims=True) + RMS_EPS)
    return y.astype(x.dtype) * gain.astype(x.dtype)


def rope_tables(length, rot_dim, dtype):
    inv = ROPE_THETA ** (-jnp.arange(0, rot_dim, 2, dtype=jnp.float32) / rot_dim)
    ang = jnp.arange(length, dtype=jnp.float32)[:, None] * inv[None, :]
    return jnp.cos(ang).astype(dtype), jnp.sin(ang).astype(dtype)


def apply_rope(t, cos, sin):
    half = cos.shape[-1]
    c = cos[None, :, None, :]
    s = sin[None, :, None, :]
    t1, t2, rest = t[..., :half], t[..., half:2 * half], t[..., 2 * half:]
    return jnp.concatenate([t1 * c - t2 * s, t2 * c + t1 * s, rest], axis=-1)


def to_query_blocks(t):
    b, l, h, d = t.shape
    return t.reshape(b, l // Q_BLOCK, Q_BLOCK, h, d).transpose(1, 0, 3, 2, 4)


def from_query_blocks(t):
    nb, b, h, qb, d = t.shape
    return t.transpose(1, 0, 3, 2, 4).reshape(b, nb * qb, h * d)


def causal_probs(qb, k, start, scale):
    s = jnp.einsum('bhqd,bhkd->bhqk', qb, k).astype(jnp.float32) * scale
    qpos = start + jnp.arange(qb.shape[2])
    kpos = jnp.arange(k.shape[2])
    mask = kpos[None, :] <= qpos[:, None]
    s = jnp.where(mask[None, None], s, -jnp.inf)
    return jax.nn.softmax(s, axis=-1)


def causal_attention(q, k, v, scale):
    kt = k.transpose(0, 2, 1, 3)
    vt = v.transpose(0, 2, 1, 3)
    qblocks = to_query_blocks(q)
    starts = jnp.arange(qblocks.shape[0]) * Q_BLOCK

    def one_block(args):
        qb, start = args
        p = causal_probs(qb, kt, start, scale)
        return jnp.einsum('bhqk,bhkd->bhqd', p.astype(vt.dtype), vt)

    return from_query_blocks(lax.map(one_block, (qblocks, starts)))


def causal_diff_attention(q1, k1, q2, k2, v, lam, scale):
    k1t = k1.transpose(0, 2, 1, 3)
    k2t = k2.transpose(0, 2, 1, 3)
    vt = v.transpose(0, 2, 1, 3)
    q1b = to_query_blocks(q1)
    q2b = to_query_blocks(q2)
    starts = jnp.arange(q1b.shape[0]) * Q_BLOCK

    def one_block(args):
        qa, qc, start = args
        p = causal_probs(qa, k1t, start, scale) - lam * causal_probs(qc, k2t, start, scale)
        return jnp.einsum('bhqk,bhkd->bhqd', p.astype(vt.dtype), vt)

    out = lax.map(one_block, (q1b, q2b, starts))
    nb, b, h, qb, d = out.shape
    return out.transpose(1, 0, 3, 2, 4).reshape(b, nb * qb, h, d)


def setup_inputs(seed: int = 0) -> dict:
    key = jax.random.key(seed)
    ks = jax.random.split(key, 20)
    f32 = jnp.float32

    def w(k, shape, fan_in):
        return jax.random.normal(k, shape, f32) * (fan_in ** -0.5)

    def gain(k, shape):
        return 1.0 + 0.02 * jax.random.normal(k, shape, f32)

    return {
        "x": jax.random.normal(ks[0], (BATCH, SEQ, D_MODEL), f32),
        "meta_tokens": jax.random.normal(ks[1], (N_META, D_MODEL), f32),
        "norm_mix_pre": gain(ks[2], (DEPTH, D_MODEL)),
        "norm_mix_post": gain(ks[3], (DEPTH, D_MODEL)),
        "norm_ffn_pre": gain(ks[4], (DEPTH, D_MODEL)),
        "norm_ffn_post": gain(ks[5], (DEPTH, D_MODEL)),
        "w_in": w(ks[6], (DEPTH, D_MODEL, IN_COLS), D_MODEL),
        "mla_q_norm": gain(ks[7], (DEPTH, MLA_Q_RANK)),
        "mla_kv_norm": gain(ks[8], (DEPTH, MLA_KV_RANK)),
        "mla_w_uq": w(ks[9], (DEPTH, MLA_Q_RANK, MLA_HEADS * (MLA_NOPE + MLA_ROPE)), MLA_Q_RANK),
        "mla_w_ukv": w(ks[10], (DEPTH, MLA_KV_RANK, MLA_HEADS * (MLA_NOPE + MLA_V)), MLA_KV_RANK),
        "w_o_mla": w(ks[11], (DEPTH, MLA_HEADS * MLA_V, D_MODEL), MLA_HEADS * MLA_V),
        "diff_lambda": 0.1 * jax.random.normal(ks[12], (DEPTH, 4, DIFF_DH), f32),
        "diff_subln": gain(ks[13], (DEPTH, 2 * DIFF_DH)),
        "w_o_diff": w(ks[14], (DEPTH, DIFF_HEADS * 2 * DIFF_DH, D_MODEL), DIFF_HEADS * 2 * DIFF_DH),
        "w_out": w(ks[15], (DEPTH, D_MODEL, D_MODEL), D_MODEL),
        "w_gate_up": w(ks[16], (DEPTH, D_MODEL, 2 * D_FF), D_MODEL),
        "w_down": w(ks[17], (DEPTH, D_FF, D_MODEL), D_FF),
    }


def reference(x, meta_tokens, norm_mix_pre, norm_mix_post, norm_ffn_pre, norm_ffn_post,
              w_in, mla_q_norm, mla_kv_norm, mla_w_uq, mla_w_ukv, w_o_mla,
              diff_lambda, diff_subln, w_o_diff, w_out, w_gate_up, w_down):
    dt = x.dtype
    b, s, d = x.shape
    length = s + N_META
    l_pad = -(-length // Q_BLOCK) * Q_BLOCK
    meta = jnp.broadcast_to(meta_tokens.astype(dt)[None], (b, N_META, d))
    r = jnp.concatenate([meta, x, jnp.zeros((b, l_pad - length, d), dt)], axis=1)

    cos_mla, sin_mla = rope_tables(l_pad, MLA_ROPE, dt)
    cos_dif, sin_dif = rope_tables(l_pad, DIFF_ROPE, dt)
    mla_scale = 1.0 / math.sqrt(MLA_NOPE + MLA_ROPE)
    diff_scale = 1.0 / math.sqrt(DIFF_DH)

    for layer in range(DEPTH):
        h = rms_norm(r, norm_mix_pre[layer])
        proj = h @ w_in[layer].astype(dt)
        (q_lat, kv_lat, k_pe, dq, dk, dv, g_a, g_b) = jnp.split(proj, SPLIT_POINTS, axis=-1)

        c_q = rms_norm(q_lat, mla_q_norm[layer])
        qa = (c_q @ mla_w_uq[layer].astype(dt)).reshape(b, l_pad, MLA_HEADS, MLA_NOPE + MLA_ROPE)
        qa = jnp.concatenate([qa[..., :MLA_NOPE], apply_rope(qa[..., MLA_NOPE:], cos_mla, sin_mla)], axis=-1)
        c_kv = rms_norm(kv_lat, mla_kv_norm[layer])
        kva = (c_kv @ mla_w_ukv[layer].astype(dt)).reshape(b, l_pad, MLA_HEADS, MLA_NOPE + MLA_V)
        k_nope, va = kva[..., :MLA_NOPE], kva[..., MLA_NOPE:]
        k_rope = apply_rope(k_pe[:, :, None, :], cos_mla, sin_mla)
        ka = jnp.concatenate(
            [k_nope, jnp.broadcast_to(k_rope, (b, l_pad, MLA_HEADS, MLA_ROPE))], axis=-1)
        out_a = causal_attention(qa, ka, va, mla_scale) @ w_o_mla[layer].astype(dt)

        qd = apply_rope(dq.reshape(b, l_pad, DIFF_HEADS * 2, DIFF_DH), cos_dif, sin_dif)
        kd = apply_rope(dk.reshape(b, l_pad, DIFF_HEADS * 2, DIFF_DH), cos_dif, sin_dif)
        qd = qd.reshape(b, l_pad, DIFF_HEADS, 2, DIFF_DH)
        kd = kd.reshape(b, l_pad, DIFF_HEADS, 2, DIFF_DH)
        vd = dv.reshape(b, l_pad, DIFF_HEADS, 2 * DIFF_DH)
        lam_init = 0.8 - 0.6 * math.exp(-0.3 * layer)
        lp = diff_lambda[layer].astype(jnp.float32)
        lam = (jnp.exp(jnp.sum(lp[0] * lp[1])) - jnp.exp(jnp.sum(lp[2] * lp[3])) + lam_init)
        od = causal_diff_attention(qd[..., 0, :], kd[..., 0, :], qd[..., 1, :], kd[..., 1, :],
                                   vd, lam, diff_scale)
        od = rms_norm(od, diff_subln[layer]) * (1.0 - lam_init)
        out_b = od.reshape(b, l_pad, DIFF_HEADS * 2 * DIFF_DH) @ w_o_diff[layer].astype(dt)

        mix = (jax.nn.sigmoid(g_a) * out_a + jax.nn.sigmoid(g_b) * out_b) @ w_out[layer].astype(dt)
        r = r + rms_norm(mix, norm_mix_post[layer])

        h = rms_norm(r, norm_ffn_pre[layer])
        gu = h @ w_gate_up[layer].astype(dt)
        ff = (jax.nn.silu(gu[..., :D_FF]) * gu[..., D_FF:]) @ w_down[layer].astype(dt)
        r = r + rms_norm(ff, norm_ffn_post[layer])

    return r[:, N_META:N_META + s, :]
```

```cpp
#include <hip/hip_runtime.h>
#include <hip/hip_cooperative_groups.h>
#include <cstdio>
#include <cstdint>
#include <cmath>
namespace cg = cooperative_groups;
__device__ __forceinline__ int launder(int x) { asm volatile("" : "+v"(x)); return x; }
__device__ __forceinline__ int launder_s(int x) { asm volatile("" : "+s"(x)); return x; }
__device__ __forceinline__ int fresh_tid(int wave) { int z = 0; asm volatile("" : "+s"(z)); return wave * 64 + (int)__builtin_amdgcn_mbcnt_hi(~0u, __builtin_amdgcn_mbcnt_lo(~0u, (unsigned)z)); }
__device__ __forceinline__ float shx(float v, int o, int lane) { return __builtin_bit_cast(float, __builtin_amdgcn_ds_bpermute((lane ^ o) << 2, __builtin_bit_cast(int, v))); }

namespace pg8 {
#define PG8_LAS __attribute__((address_space(3)))
typedef unsigned short bf16_t;
typedef short bf16x8 __attribute__((ext_vector_type(8)));
typedef float f32x4 __attribute__((ext_vector_type(4)));
typedef unsigned u32x4 __attribute__((ext_vector_type(4)));
constexpr int BM = 256, BK = 64, HALF = 128, HTB = HALF * BK * 2  , STAGE_BYTES = 8 * HTB, NXCD = 8, WGM = 8;

__host__ __device__ __forceinline__ int lds_byte(int r, int c) { const int st = (r >> 4) * 2 + (c >> 5), rr = r & 15, cc = c & 31, ob = rr * 64 + cc * 2; return st * 1024 + (ob ^ (((ob >> 9) & 1) << 5)); }
__host__ __device__ __forceinline__ void stage_rc(int b, int& R, int& C) { const int st = b / 1024, sb = b % 1024, swz = sb ^ (((sb >> 9) & 1) << 5); R = (st >> 1) * 16 + swz / 64; C = (st & 1) * 32 + (swz % 64) / 2; }
__host__ __device__ __forceinline__ int perm32(int rho) { const int n = rho >> 4, i = rho & 15; return 8 * (i >> 2) + 4 * n + (i & 3); }

struct Unit { int pm, pn; };
struct Gemm { const bf16_t* A; const bf16_t* Bt; int M, N, K; };

struct StaticOrder {
    int nM, nN, nwg, G, c;
    __host__ __device__ void init(int M, int N, int G_, int c_) { nM = M / BM; nN = N / BM; nwg = nM * nN; G = G_; c = c_; }
    __host__ __device__ bool next(int i, Unit& u) const {
        const long L = (long)i * G + c; if (L >= nwg) return false;
        int wgid = (int)L; { const int q = nwg / NXCD, r = nwg % NXCD, xcd = wgid % NXCD, off = wgid / NXCD; wgid = (xcd < r ? xcd * (q + 1) : r * (q + 1) + (xcd - r) * q) + off; }
        const int nig = WGM * nN, gid = wgid / nig, fm = gid * WGM, gsz = (nM - fm) < WGM ? (nM - fm) : WGM;
        u.pm = fm + ((wgid % nig) % gsz); u.pn = (wgid % nig) / gsz; return true;
    }
    __device__ __forceinline__ void a_ready(const Unit&) const {}
    __device__ __forceinline__ void done(const Unit&) const {}
};

typedef float f32x2 __attribute__((ext_vector_type(2)));
typedef __bf16 bf16x2_t __attribute__((ext_vector_type(2)));
__device__ __forceinline__ unsigned cvt_pk_bf16(float lo, float hi) { f32x2 v = {lo, hi}; bf16x2_t b = __builtin_convertvector(v, bf16x2_t); return __builtin_bit_cast(unsigned, b); }
template <class Epi, class Sched, bool ALIGN_EPI = false, bool SP2 = false>
__device__ __forceinline__ void gemm_phase(PG8_LAS unsigned char* lds, const Gemm g, const Sched& S, const Epi& E, int wave_) {
    const int tid = fresh_tid(wave_), wid = __builtin_amdgcn_readfirstlane(tid >> 6), lane = tid & 63, wr = wid >> 2, wc = wid & 3, fr = lane & 15, fq = lane >> 4;
    const int K = g.K, nt = K / BK;
    unsigned voffA[2], voffB[2];
#pragma unroll
    for (int i = 0; i < 2; ++i) { int R, C; stage_rc(tid * 16 + i * 8192, R, C); const int Rb = Epi::PERM ? ((R & ~31) + perm32(R & 31)) : R;
        voffA[i] = (unsigned)(R * K + C) * 2u; voffB[i] = (unsigned)(Rb * K + C) * 2u; }
    const size_t kstep = (size_t)(BK * 2);
    const size_t hstep = (size_t)HALF * K * 2;
    const size_t tstep = 2 * hstep;
    const unsigned ldsw = (unsigned)wid * 1024u;
    const int aoff = lds_byte(wr * 64 + fr, fq * 8), boff = lds_byte(wc * 32 + fr, fq * 8);
#define PG8_SA(b, h) (((b) * 2 + (h)) * HTB)
#define PG8_SB(b, h) ((4 + (b) * 2 + (h)) * HTB)
#define PG8_STAGE(bufoff, gbase, voff) do { _Pragma("unroll") for (int _i = 0; _i < 2; ++_i) \
        __builtin_amdgcn_global_load_lds((const unsigned*)((const char*)(gbase) + (voff)[_i]), (PG8_LAS unsigned*)(lds + (bufoff) + ldsw + _i * 8192), 16, 0, 0); } while (0)
#define PG8_LDA(dst, b, h) do { _Pragma("unroll") for (int m = 0; m < 4; ++m) _Pragma("unroll") for (int k = 0; k < 2; ++k) dst[m][k] = *(const PG8_LAS bf16x8*)(lds + PG8_SA(b, h) + aoff + m * 2048 + k * 1024); } while (0)
#define PG8_LDB(dst, b, h) do { _Pragma("unroll") for (int n = 0; n < 2; ++n) _Pragma("unroll") for (int k = 0; k < 2; ++k) dst[n][k] = *(const PG8_LAS bf16x8*)(lds + PG8_SB(b, h) + boff + n * 2048 + k * 1024); } while (0)
#define PG8_MMA(ai, bj, At, Bt) do { __builtin_amdgcn_s_setprio(1); _Pragma("unroll") for (int m = 0; m < 4; ++m) _Pragma("unroll") for (int n = 0; n < 2; ++n) _Pragma("unroll") for (int k = 0; k < 2; ++k) \
        acc[ai][bj][m][n] = __builtin_amdgcn_mfma_f32_16x16x32_bf16(Bt[n][k], At[m][k], acc[ai][bj][m][n], 0, 0, 0); __builtin_amdgcn_s_setprio(0); } while (0)
#define PG8_WAIT_V(n) asm volatile("s_waitcnt vmcnt(" #n ")" ::: "memory")
#define PG8_WAIT_L(n) asm volatile("s_waitcnt lgkmcnt(" #n ")" ::: "memory")
#define PG8_BAR __builtin_amdgcn_s_barrier()
#define PG8_SCHED __builtin_amdgcn_sched_barrier(0)
    Unit cur, nxt; int ui = 0;
    if (!S.next(0, cur)) return;
    f32x4 acc[2][2][4][2];
#pragma unroll
    for (int a = 0; a < 2; ++a)
#pragma unroll
        for (int b = 0; b < 2; ++b)
#pragma unroll
            for (int m = 0; m < 4; ++m)
#pragma unroll
                for (int n = 0; n < 2; ++n) acc[a][b][m][n] = (f32x4){0.f, 0.f, 0.f, 0.f};
    bf16x8 At[4][2], B0[2][2], B1[2][2];
    const char* cA = (const char*)g.A + (size_t)cur.pm * tstep; const char* cB = (const char*)g.Bt + (size_t)cur.pn * tstep;
    S.a_ready(cur);
    if constexpr (SP2) {
        PG8_STAGE(PG8_SB(0, 0), cB, voffB); PG8_STAGE(PG8_SB(0, 1), cB + hstep, voffB); PG8_STAGE(PG8_SA(0, 0), cA, voffA); PG8_STAGE(PG8_SA(0, 1), cA + hstep, voffA);
        if (wr == 1) PG8_BAR;
        PG8_WAIT_V(2); PG8_BAR;
        PG8_STAGE(PG8_SB(1, 0), cB + kstep, voffB); PG8_STAGE(PG8_SA(1, 0), cA + kstep, voffA); PG8_STAGE(PG8_SB(1, 1), cB + hstep + kstep, voffB);
        PG8_WAIT_V(6); PG8_BAR;
    } else {
        PG8_STAGE(PG8_SB(0, 0), cB, voffB); PG8_STAGE(PG8_SA(0, 0), cA, voffA); PG8_STAGE(PG8_SB(0, 1), cB + hstep, voffB); PG8_STAGE(PG8_SA(0, 1), cA + hstep, voffA);
        if (wr == 1) PG8_BAR;
        PG8_WAIT_V(4); PG8_BAR;
        PG8_STAGE(PG8_SB(1, 0), cB + kstep, voffB); PG8_STAGE(PG8_SA(1, 0), cA + kstep, voffA); PG8_STAGE(PG8_SB(1, 1), cB + hstep + kstep, voffB);
        PG8_WAIT_V(6); PG8_BAR;
    }
    for (;;) {
        const bool has_next = S.next(ui + 1, nxt);
        const char* nA = has_next ? (const char*)g.A + (size_t)nxt.pm * tstep : cA; const char* nB = has_next ? (const char*)g.Bt + (size_t)nxt.pn * tstep : cB;
        for (int t = 0; t < nt; t += 2) {
            const bool last = (t == nt - 2);
            const char* a1 = cA + (size_t)(t + 1) * kstep;
            const char* a2 = last ? nA : cA + (size_t)(t + 2) * kstep; const char* b2 = last ? nB : cB + (size_t)(t + 2) * kstep;
            const char* a3 = a2 + kstep; const char* b3 = b2 + kstep;
            if (last && has_next) S.a_ready(nxt);
            if constexpr (SP2) {
            PG8_LDB(B0, 0, 0); PG8_LDB(B1, 0, 1); PG8_SCHED; PG8_LDA(At, 0, 0); PG8_STAGE(PG8_SA(1, 1), a1 + hstep, voffA);
            PG8_WAIT_V(8); PG8_WAIT_L(0); PG8_BAR; PG8_MMA(0, 0, At, B0); PG8_MMA(0, 1, At, B1); PG8_BAR; PG8_SCHED;
            PG8_LDA(At, 0, 1); PG8_STAGE(PG8_SB(0, 0), b2, voffB); PG8_STAGE(PG8_SB(0, 1), b2 + hstep, voffB); PG8_STAGE(PG8_SA(0, 0), a2, voffA);
            PG8_WAIT_V(8); PG8_WAIT_L(0); PG8_BAR; PG8_MMA(1, 0, At, B0); PG8_MMA(1, 1, At, B1); PG8_BAR; PG8_SCHED;
            PG8_LDB(B0, 1, 0); PG8_LDB(B1, 1, 1); PG8_SCHED; PG8_LDA(At, 1, 0); PG8_STAGE(PG8_SA(0, 1), a2 + hstep, voffA);
            PG8_WAIT_V(8); PG8_WAIT_L(0); PG8_BAR; PG8_MMA(0, 0, At, B0); PG8_MMA(0, 1, At, B1); PG8_BAR; PG8_SCHED;
            PG8_LDA(At, 1, 1); PG8_STAGE(PG8_SB(1, 0), b3, voffB); PG8_STAGE(PG8_SB(1, 1), b3 + hstep, voffB); PG8_STAGE(PG8_SA(1, 0), a3, voffA);
            PG8_WAIT_V(8); PG8_WAIT_L(0); PG8_BAR; PG8_MMA(1, 0, At, B0); PG8_MMA(1, 1, At, B1); PG8_BAR; PG8_SCHED;
            } else {
            PG8_LDB(B0, 0, 0); PG8_SCHED; PG8_LDA(At, 0, 0); PG8_STAGE(PG8_SA(1, 1), a1 + hstep, voffA);
            PG8_WAIT_L(8); PG8_BAR; PG8_WAIT_L(0); PG8_MMA(0, 0, At, B0); PG8_BAR; PG8_SCHED;
            PG8_LDB(B1, 0, 1); PG8_STAGE(PG8_SB(0, 0), b2, voffB);
            PG8_BAR; PG8_WAIT_L(0); PG8_MMA(0, 1, At, B1); PG8_BAR;
            PG8_LDA(At, 0, 1); PG8_STAGE(PG8_SA(0, 0), a2, voffA);
            PG8_BAR; PG8_WAIT_L(0); PG8_MMA(1, 0, At, B0); PG8_BAR; PG8_SCHED;
            PG8_STAGE(PG8_SB(0, 1), b2 + hstep, voffB);
            PG8_WAIT_V(6); PG8_BAR; PG8_MMA(1, 1, At, B1); PG8_BAR;
            PG8_LDB(B0, 1, 0); PG8_SCHED; PG8_LDA(At, 1, 0); PG8_STAGE(PG8_SA(0, 1), a2 + hstep, voffA);
            PG8_WAIT_L(8); PG8_BAR; PG8_WAIT_L(0); PG8_MMA(0, 0, At, B0); PG8_BAR; PG8_SCHED;
            PG8_LDB(B1, 1, 1); PG8_STAGE(PG8_SB(1, 0), b3, voffB);
            PG8_BAR; PG8_WAIT_L(0); PG8_MMA(0, 1, At, B1); PG8_BAR;
            PG8_LDA(At, 1, 1); PG8_STAGE(PG8_SA(1, 0), a3, voffA);
            PG8_BAR; PG8_WAIT_L(0); PG8_MMA(1, 0, At, B0); PG8_BAR; PG8_SCHED;
            PG8_STAGE(PG8_SB(1, 1), b3 + hstep, voffB);
            PG8_WAIT_V(6); PG8_BAR; PG8_MMA(1, 1, At, B1); PG8_BAR;
            }
        }
        if constexpr (ALIGN_EPI) { if (wr == 0) PG8_BAR; }
        if constexpr (!Epi::AFTER_DRAIN) { E(acc, cur, wr, wc, fr, fq); S.done(cur); }
        if (!has_next) break;
#pragma unroll
        for (int a = 0; a < 2; ++a)
#pragma unroll
            for (int b = 0; b < 2; ++b)
#pragma unroll
                for (int m = 0; m < 4; ++m)
#pragma unroll
                    for (int n = 0; n < 2; ++n) acc[a][b][m][n] = (f32x4){0.f, 0.f, 0.f, 0.f};
        cur = nxt; cA = nA; cB = nB; ++ui;
        if constexpr (ALIGN_EPI) { if (wr == 1) PG8_BAR; }
    }
    PG8_WAIT_V(0);
    if constexpr (!ALIGN_EPI) { if (wr == 0) PG8_BAR; }
    PG8_BAR;
    if constexpr (Epi::AFTER_DRAIN) { E.fused(acc, cur, wr, wc, fr, fq, lds, wid, lane); S.done(cur); }
#undef PG8_SA
#undef PG8_SB
#undef PG8_STAGE
#undef PG8_LDA
#undef PG8_LDB
#undef PG8_MMA
#undef PG8_WAIT_V
#undef PG8_WAIT_L
#undef PG8_BAR
#undef PG8_SCHED
}
}

using pg8::bf16_t; using pg8::f32x4; using pg8::u32x4; using pg8::bf16x8; using pg8::Unit; using pg8::cvt_pk_bf16;
#define LAS __attribute__((address_space(3)))
constexpr int DM = 1024, NB = 8, SEQ = 4096, NMETA = 16, M0 = NB * SEQ  , MP = M0 + 256  , MVALID = M0 + NMETA;
constexpr int DFF = 2816, NLAYER = 2;
constexpr float EPS = 1e-6f, LOG2E = 1.4426950408889634f;
constexpr float MLA_QSCALE = 0.10206207261596575f * LOG2E;
constexpr float DIFF_QSCALE = 0.125f * LOG2E;
constexpr int NPOS = 4352;
enum { I_X = 0, I_META, I_NMIXPRE, I_NMIXPOST, I_NFFNPRE, I_NFFNPOST, I_WIN, I_QNORM, I_KVNORM, I_WUQ, I_WUKV, I_WOMLA, I_LAMBDA, I_SUBLN, I_WODIFF, I_WOUT, I_WGU, I_WDOWN };
constexpr size_t QMiB = 1u << 18;
constexpr size_t WS_BAR = 14 * QMiB  , WS_BAR_BYTES = 16384;
constexpr size_t WS_LAM = 0, WS_ROPE = 4096, WS_SSQQ = 4 * QMiB  , WS_SSQKV = 9 * QMiB  , WS_RM = 12 * QMiB, WS_W = 16 * QMiB, WS_WSTRIDE = 124 * QMiB;
constexpr size_t WO_INA = 0, WO_INB = 18 * QMiB, WO_UQ = 34 * QMiB, WO_UKV = 37 * QMiB, WO_OMLA = 40 * QMiB, WO_ODIFF = 44 * QMiB, WO_OUT = 48 * QMiB, WO_GU = 56 * QMiB, WO_DOWN = 100 * QMiB;
constexpr size_t WS_XN = 264 * QMiB;
constexpr size_t WS_QD = 524 * QMiB, WS_KD = 654 * QMiB, WS_VD = 784 * QMiB, WS_QA = 914 * QMiB, WS_KA = 1109 * QMiB, WS_VA = 1304 * QMiB, WS_QL = 1434 * QMiB, WS_KVL = 1532 * QMiB;
constexpr size_t WS_AOA = 1600 * QMiB, WS_AOB = 1730 * QMiB, WS_G = 524 * QMiB, WS_MIXIN = 1044 * QMiB, WS_MIX = 1304 * QMiB, WS_FF = 524 * QMiB, WS_FFO = 1304 * QMiB;
constexpr size_t WS_O1 = 1860 * QMiB;
constexpr size_t WS_END = 1988 * QMiB;
static_assert(WS_QD + (size_t)MP * 512 * 2 <= WS_KD && WS_KD + (size_t)MP * 512 * 2 <= WS_VD && WS_VD + (size_t)MP * 512 * 2 <= WS_QA && WS_QA + (size_t)MP * 768 * 2 <= WS_KA && WS_KA + (size_t)MP * 768 * 2 <= WS_VA, "map1");
static_assert(WS_VA + (size_t)MP * 512 * 2 <= WS_QL && WS_QL + (size_t)MP * 384 * 2 <= WS_KVL && WS_KVL + (size_t)MP * 256 * 2 <= WS_AOA && WS_AOA + (size_t)MP * 512 * 2 <= WS_AOB && WS_AOB + (size_t)MP * 512 * 2 <= WS_O1, "map2");
static_assert(WS_G + (size_t)MP * 2048 * 2 <= WS_MIXIN && WS_MIXIN + (size_t)MP * 1024 * 2 <= WS_MIX && WS_MIX + (size_t)MP * 1024 * 2 <= WS_AOA && WS_FF + (size_t)MP * DFF * 2 <= WS_FFO && WS_XN + (size_t)MP * 1024 * 2 <= WS_QD, "map3");
static_assert(WO_INA + 2304 * 1024 * 2 <= WO_INB && WO_INB + 2048 * 1024 * 2 <= WO_UQ && WO_UQ + 768 * 384 * 2 <= WO_UKV && WO_UKV + 1024 * 256 * 2 <= WO_OMLA && WO_GU + 5632 * 1024 * 2 <= WO_DOWN && WO_DOWN + 1024 * 2816 * 2 <= WS_WSTRIDE, "wmap");
static_assert(WS_W + 2 * WS_WSTRIDE <= WS_XN && WS_ROPE + (size_t)NPOS * 24 * 8 <= WS_SSQQ && WS_SSQQ + (size_t)MP * 8 * 4 <= WS_SSQKV && WS_SSQKV + (size_t)MP * 4 * 4 <= WS_RM, "map4");

struct Params { const float* in[18]; float* out; unsigned char* ws; double invrev[24]; };

__device__ __forceinline__ unsigned f2bf(float f) { unsigned u = __builtin_bit_cast(unsigned, f); return (u + 0x7fffu + ((u >> 16) & 1u)) >> 16; }
__device__ __forceinline__ unsigned pk2(float lo, float hi) { return f2bf(lo) | (f2bf(hi) << 16); }
__device__ __forceinline__ float bflo(unsigned w) { return __builtin_bit_cast(float, w << 16); }
__device__ __forceinline__ float bfhi(unsigned w) { return __builtin_bit_cast(float, w & 0xffff0000u); }
__device__ __forceinline__ void st8(bf16_t* p, f32x4 v0, f32x4 v1) {
    u32x4 w; w.x = cvt_pk_bf16(v0[0], v0[1]); w.y = cvt_pk_bf16(v0[2], v0[3]); w.z = cvt_pk_bf16(v1[0], v1[1]); w.w = cvt_pk_bf16(v1[2], v1[3]); *(u32x4*)p = w; }
__device__ __forceinline__ void ld8(const bf16_t* p, f32x4& v0, f32x4& v1) {
    const u32x4 w = *(const u32x4*)p; v0 = (f32x4){bflo(w.x), bfhi(w.x), bflo(w.y), bfhi(w.y)}; v1 = (f32x4){bflo(w.z), bfhi(w.z), bflo(w.w), bfhi(w.w)}; }
__device__ __forceinline__ float sigmoidf_(float x) { return __builtin_amdgcn_rcpf(1.0f + __builtin_amdgcn_exp2f(-x * LOG2E)); }
__device__ __forceinline__ int row_pos(int row) { return row < M0 ? NMETA + (row & (SEQ - 1)) : row - M0; }
__device__ __forceinline__ void rope4(f32x4& v0, f32x4& v1, const float* t) {
    const f32x4 c0 = *(const f32x4*)t, c1 = *(const f32x4*)(t + 4);
    float a, b;
    a = v0[0]; b = v0[1]; v0[0] = a * c0[0] - b * c0[1]; v0[1] = b * c0[0] + a * c0[1];
    a = v0[2]; b = v0[3]; v0[2] = a * c0[2] - b * c0[3]; v0[3] = b * c0[2] + a * c0[3];
    a = v1[0]; b = v1[1]; v1[0] = a * c1[0] - b * c1[1]; v1[1] = b * c1[0] + a * c1[1];
    a = v1[2]; b = v1[3]; v1[2] = a * c1[2] - b * c1[3]; v1[3] = b * c1[2] + a * c1[3];
}
__device__ __forceinline__ float sumsq4(f32x4 v) { return (v[0] * v[0] + v[1] * v[1]) + (v[2] * v[2] + v[3] * v[3]); }
__device__ __forceinline__ float wave_sum(float v, int lane) {
#pragma unroll
    for (int o = 1; o < 64; o <<= 1) v += shx(v, o, lane);
    return v;
}

typedef const f32x4 (&AccRef)[2][2][4][2];
struct EpiPlain {
    static constexpr bool PERM = true, AFTER_DRAIN = false;
    bf16_t* O; int ldc;
    __device__ __forceinline__ void operator()(AccRef acc, const Unit& u, int wr, int wc, int fr_, int fq_) const { run<false>(acc, u, wr, wc, fr_, fq_); }
    template <bool MINI> __device__ __forceinline__ void run(AccRef acc, const Unit& u, int wr, int wc, int fr_, int fq_) const {
        const int ln_ = fresh_tid(0), fr = ln_ & 15, fq = ln_ >> 4; (void)fr_; (void)fq_;
        const int row0 = u.pm * 256 + wr * 64 + fr, colw = u.pn * 256 + wc * 32 + 8 * fq;
#pragma unroll
        for (int ai = 0; ai < (MINI ? 1 : 2); ++ai)
#pragma unroll
            for (int m = 0; m < (MINI ? 1 : 4); ++m) { const int row = row0 + ai * 128 + m * 16;
#pragma unroll
                for (int bj = 0; bj < 2; ++bj) st8(O + (size_t)row * ldc + colw + bj * 128, acc[ai][bj][m][0], acc[ai][bj][m][1]); }
    }
};
struct EpiInA {
    static constexpr bool PERM = true, AFTER_DRAIN = false;
    bf16_t *QD, *KD, *VD, *KVL, *QL, *KA; float *ssq_q, *ssq_kv; const float* rope;
    template <bool MINI> static __device__ __forceinline__ void lat(AccRef acc, bf16_t* dst, int ld, float* sq, int nslot, int slot, int row0, int cw, int fr, int fq) {
#pragma unroll
        for (int ai = 0; ai < (MINI ? 1 : 2); ++ai)
#pragma unroll
            for (int m = 0; m < (MINI ? 1 : 4); ++m) { const int row = row0 + ai * 128 + m * 16; float s = 0.f;
#pragma unroll
                for (int bj = 0; bj < 2; ++bj) { const f32x4 v0 = acc[ai][bj][m][0], v1 = acc[ai][bj][m][1]; s += sumsq4(v0) + sumsq4(v1); st8(dst + (size_t)row * ld + bj * 128 + cw, v0, v1); }
                s += shx(s, 16, fr + 16 * fq); s += shx(s, 32, fr + 16 * fq);
                if (fq == 0) sq[(size_t)row * nslot + slot] = s; }
    }
    __device__ __forceinline__ void operator()(AccRef acc, const Unit& u, int wr, int wc, int fr_, int fq_) const { run<false>(acc, u, wr, wc, fr_, fq_); }
    template <bool MINI> __device__ __forceinline__ void run(AccRef acc, const Unit& u, int wr, int wc, int fr_, int fq_) const {
        const int ln_ = fresh_tid(0), fr = ln_ & 15, fq = ln_ >> 4; (void)fr_; (void)fq_;
        const int pn = u.pn, row0 = u.pm * 256 + wr * 64 + fr, cw = wc * 32 + 8 * fq;
        if (pn < 6) {
            static_assert(WS_KD - WS_QD == WS_VD - WS_KD, "QD/KD/VD equally spaced");
            bf16_t* dst = QD + (size_t)(pn >> 1) * ((WS_KD - WS_QD) / 2);
            const int cbase = (pn & 1) * 256;
            const bool dorope = (pn < 4) && ((wc & 1) == 0) && (fq < 2);
            const float sc = pn < 2 ? DIFF_QSCALE : 1.0f;
#pragma unroll
            for (int ai = 0; ai < (MINI ? 1 : 2); ++ai)
#pragma unroll
                for (int m = 0; m < (MINI ? 1 : 4); ++m) { const int row = row0 + ai * 128 + m * 16; const float* rt = rope + (size_t)row_pos(row) * 48 + 2 * (16 + 4 * fq);
#pragma unroll
                    for (int bj = 0; bj < 2; ++bj) { f32x4 v0 = acc[ai][bj][m][0], v1 = acc[ai][bj][m][1];
                        if (dorope) rope4(v0, v1, rt);
                        v0 = v0 * sc; v1 = v1 * sc; st8(dst + (size_t)row * 512 + cbase + bj * 128 + cw, v0, v1); } }
        } else if (pn == 6) { lat<MINI>(acc, KVL, 256, ssq_kv, 4, wc, row0, cw, fr, fq);
        } else if (pn == 7) { lat<MINI>(acc, QL, 384, ssq_q, 8, wc, row0, cw, fr, fq);
        } else {
#pragma unroll
            for (int ai = 0; ai < (MINI ? 1 : 2); ++ai)
#pragma unroll
                for (int m = 0; m < (MINI ? 1 : 4); ++m) { const int row = row0 + ai * 128 + m * 16;
                    { const f32x4 v0 = acc[ai][0][m][0], v1 = acc[ai][0][m][1]; float s = sumsq4(v0) + sumsq4(v1); st8(QL + (size_t)row * 384 + 256 + cw, v0, v1);
                      s += shx(s, 16, fr + 16 * fq); s += shx(s, 32, fr + 16 * fq);
                      if (fq == 0) ssq_q[(size_t)row * 8 + 4 + wc] = s; }
                    if (wc == 0) { f32x4 v0 = acc[ai][1][m][0], v1 = acc[ai][1][m][1]; rope4(v0, v1, rope + (size_t)row_pos(row) * 48 + 2 * (4 * fq));
                        u32x4 w; w.x = cvt_pk_bf16(v0[0], v0[1]); w.y = cvt_pk_bf16(v0[2], v0[3]); w.z = cvt_pk_bf16(v1[0], v1[1]); w.w = cvt_pk_bf16(v1[2], v1[3]);
#pragma unroll
                        for (int h = 0; h < 8; ++h) *(u32x4*)(KA + (size_t)row * 768 + h * 96 + 64 + 8 * fq) = w; } }
        }
    }
};
struct EpiQA {
    static constexpr bool PERM = true, AFTER_DRAIN = false;
    bf16_t* QA; const float* ssq_q; const float* rope;
    __device__ __forceinline__ void operator()(AccRef acc, const Unit& u, int wr, int wc, int fr_, int fq_) const { run<false>(acc, u, wr, wc, fr_, fq_); }
    template <bool MINI> __device__ __forceinline__ void run(AccRef acc, const Unit& u, int wr, int wc, int fr_, int fq_) const {
        const int ln_ = fresh_tid(0), fr = ln_ & 15, fq = ln_ >> 4; (void)fr_; (void)fq_;
        const int row0 = u.pm * 256 + wr * 64 + fr, colw = u.pn * 256 + wc * 32 + 8 * fq;
#pragma unroll
        for (int ai = 0; ai < (MINI ? 1 : 2); ++ai)
#pragma unroll
            for (int m = 0; m < (MINI ? 1 : 4); ++m) { const int row = row0 + ai * 128 + m * 16; const f32x4 sa = *(const f32x4*)(ssq_q + (size_t)row * 8), sb = *(const f32x4*)(ssq_q + (size_t)row * 8 + 4); const float rs = rsqrtf((((sa[0] + sa[1]) + (sa[2] + sa[3])) + ((sb[0] + sb[1]) + (sb[2] + sb[3]))) * (1.0f / 384.0f) + EPS) * MLA_QSCALE; const float* rt = rope + (size_t)row_pos(row) * 48;
#pragma unroll
                for (int bj = 0; bj < 2; ++bj) { const int col = colw + bj * 128, j = col % 96; f32x4 v0 = acc[ai][bj][m][0] * rs, v1 = acc[ai][bj][m][1] * rs;
                    if (j >= 64) rope4(v0, v1, rt + (j - 64));
                    st8(QA + (size_t)row * 768 + col, v0, v1); } }
    }
};
struct EpiKV {
    static constexpr bool PERM = true, AFTER_DRAIN = false;
    bf16_t *KA, *VA; const float* ssq_kv;
    __device__ __forceinline__ void operator()(AccRef acc, const Unit& u, int wr, int wc, int fr_, int fq_) const { run<false>(acc, u, wr, wc, fr_, fq_); }
    template <bool MINI> __device__ __forceinline__ void run(AccRef acc, const Unit& u, int wr, int wc, int fr_, int fq_) const {
        const int ln_ = fresh_tid(0), fr = ln_ & 15, fq = ln_ >> 4; (void)fr_; (void)fq_;
        const int row0 = u.pm * 256 + wr * 64 + fr, colw = u.pn * 256 + wc * 32 + 8 * fq;
#pragma unroll
        for (int ai = 0; ai < (MINI ? 1 : 2); ++ai)
#pragma unroll
            for (int m = 0; m < (MINI ? 1 : 4); ++m) { const int row = row0 + ai * 128 + m * 16; const f32x4 sa = *(const f32x4*)(ssq_kv + (size_t)row * 4); const float rs = rsqrtf(((sa[0] + sa[1]) + (sa[2] + sa[3])) * (1.0f / 256.0f) + EPS);
#pragma unroll
                for (int bj = 0; bj < 2; ++bj) { const int c = colw + bj * 128; const f32x4 v0 = acc[ai][bj][m][0] * rs, v1 = acc[ai][bj][m][1] * rs;
                    bf16_t* dst = (u.pn < 2) ? KA + (size_t)row * 768 + (c >> 6) * 96 + (c & 63) : VA + (size_t)row * 512 + (c - 512);
                    st8(dst, v0, v1); } }
    }
};
struct EpiGate {
    static constexpr bool PERM = true, AFTER_DRAIN = false;
    bf16_t* G; int goff;
    __device__ __forceinline__ void operator()(AccRef acc, const Unit& u, int wr, int wc, int fr_, int fq_) const { run<false>(acc, u, wr, wc, fr_, fq_); }
    template <bool MINI> __device__ __forceinline__ void run(AccRef acc, const Unit& u, int wr, int wc, int fr_, int fq_) const {
        const int ln_ = fresh_tid(0), fr = ln_ & 15, fq = ln_ >> 4; (void)fr_; (void)fq_;
        const int row0 = u.pm * 256 + wr * 64 + fr, colw = u.pn * 256 + wc * 32 + 8 * fq;
#pragma unroll
        for (int ai = 0; ai < (MINI ? 1 : 2); ++ai)
#pragma unroll
            for (int m = 0; m < (MINI ? 1 : 4); ++m) { const int row = row0 + ai * 128 + m * 16;
#pragma unroll
                for (int bj = 0; bj < 2; ++bj) { f32x4 v0 = acc[ai][bj][m][0], v1 = acc[ai][bj][m][1];
#pragma unroll
                    for (int e = 0; e < 4; ++e) { v0[e] = sigmoidf_(v0[e]); v1[e] = sigmoidf_(v1[e]); }
                    st8(G + (size_t)row * 2048 + goff + colw + bj * 128, v0, v1); } }
    }
};
template <bool ADD> struct EpiMix {
    static constexpr bool PERM = true, AFTER_DRAIN = false;
    bf16_t* MIXIN; const bf16_t* G; int goff;
    __device__ __forceinline__ void operator()(AccRef acc, const Unit& u, int wr, int wc, int fr_, int fq_) const { run<false>(acc, u, wr, wc, fr_, fq_); }
    template <bool MINI> __device__ __forceinline__ void run(AccRef acc, const Unit& u, int wr, int wc, int fr_, int fq_) const {
        const int ln_ = fresh_tid(0), fr = ln_ & 15, fq = ln_ >> 4; (void)fr_; (void)fq_;
        const int row0 = u.pm * 256 + wr * 64 + fr, colw = u.pn * 256 + wc * 32 + 8 * fq;
#pragma unroll
        for (int ai = 0; ai < (MINI ? 1 : 2); ++ai)
#pragma unroll
            for (int m = 0; m < (MINI ? 1 : 4); ++m) { const int row = row0 + ai * 128 + m * 16;
#pragma unroll
                for (int bj = 0; bj < 2; ++bj) { const int col = colw + bj * 128; f32x4 g0, g1; ld8(G + (size_t)row * 2048 + goff + col, g0, g1);
                    f32x4 v0 = acc[ai][bj][m][0] * g0, v1 = acc[ai][bj][m][1] * g1;
                    if (ADD) { f32x4 p0, p1; ld8(MIXIN + (size_t)row * 1024 + col, p0, p1); v0 = v0 + p0; v1 = v1 + p1; }
                    st8(MIXIN + (size_t)row * 1024 + col, v0, v1); } }
    }
};
struct EpiSwiglu {
    static constexpr bool PERM = true, AFTER_DRAIN = false;
    bf16_t* FF;
    __device__ __forceinline__ void operator()(AccRef acc, const Unit& u, int wr, int wc, int fr_, int fq_) const { run<false>(acc, u, wr, wc, fr_, fq_); }
    template <bool MINI> __device__ __forceinline__ void run(AccRef acc, const Unit& u, int wr, int wc, int fr_, int fq_) const {
        const int ln_ = fresh_tid(0), fr = ln_ & 15, fq = ln_ >> 4; (void)fr_; (void)fq_;
        const int row0 = u.pm * 256 + wr * 64 + fr, col = u.pn * 128 + wc * 32 + 8 * fq;
#pragma unroll
        for (int ai = 0; ai < (MINI ? 1 : 2); ++ai)
#pragma unroll
            for (int m = 0; m < (MINI ? 1 : 4); ++m) { const int row = row0 + ai * 128 + m * 16;
                f32x4 g0 = acc[ai][0][m][0], g1 = acc[ai][0][m][1]; const f32x4 u0 = acc[ai][1][m][0], u1 = acc[ai][1][m][1];
#pragma unroll
                for (int e = 0; e < 4; ++e) { g0[e] = g0[e] * sigmoidf_(g0[e]) * u0[e]; g1[e] = g1[e] * sigmoidf_(g1[e]) * u1[e]; }
                st8(FF + (size_t)row * DFF + col, g0, g1); }
    }
};

template <class Epi> __device__ __forceinline__ void mini_gemm(LAS unsigned char* lds, int wave_, const bf16_t* __restrict__ A, const bf16_t* __restrict__ Bt, int N, int K, const Epi& E) {
    const int nunits = (N / 256) * 4, mu = launder_s((int)gridDim.x - 1 - (int)blockIdx.x);
    if (mu >= nunits) return;
    const int pn = mu >> 2, wc = mu & 3, lane = fresh_tid(0), fr = lane & 15, fq = lane >> 4;
    const int wave = launder_s(wave_); const bool w0 = wave == 0;
    f32x4 acc[2][2][4][2];
#pragma unroll
    for (int bj = 0; bj < 2; ++bj)
#pragma unroll
        for (int n = 0; n < 2; ++n) acc[0][bj][0][n] = (f32x4){0.f, 0.f, 0.f, 0.f};
    const bf16_t* ap = A + (size_t)(M0 + fr) * K + 8 * fq;
    const bf16_t* bp = Bt + (size_t)(256 * pn + 32 * wc + 8 * (fr >> 2) + (fr & 3)) * K + 8 * fq;
    for (int kb0 = 32 * wave; kb0 < K; kb0 += 1024) {
        bf16x8 a[4], b[4][4];
#pragma unroll
        for (int t = 0; t < 4; ++t) { const int k0 = kb0 + 256 * t;
            if (k0 < K) { a[t] = *(const bf16x8*)(ap + k0);
#pragma unroll
                for (int q = 0; q < 4; ++q) b[t][q] = *(const bf16x8*)(bp + (size_t)(128 * (q >> 1) + 4 * (q & 1)) * K + k0); } }
#pragma unroll
        for (int t = 0; t < 4; ++t) { const int k0 = kb0 + 256 * t;
            if (k0 < K) {
#pragma unroll
                for (int q = 0; q < 4; ++q) acc[0][q >> 1][0][q & 1] = __builtin_amdgcn_mfma_f32_16x16x32_bf16(b[t][q], a[t], acc[0][q >> 1][0][q & 1], 0, 0, 0); } }
    }
    LAS f32x4* part = (LAS f32x4*)lds;
#pragma unroll
    for (int bj = 0; bj < 2; ++bj)
#pragma unroll
        for (int n = 0; n < 2; ++n) part[(wave * 4 + bj * 2 + n) * 64 + lane] = acc[0][bj][0][n];
    __syncthreads();
    if (w0) {
#pragma unroll
        for (int bj = 0; bj < 2; ++bj)
#pragma unroll
            for (int n = 0; n < 2; ++n) { f32x4 t = part[(bj * 2 + n) * 64 + lane];
#pragma unroll
                for (int w = 1; w < 8; ++w) t = t + part[(w * 4 + bj * 2 + n) * 64 + lane];
                acc[0][bj][0][n] = t; }
    }
    __syncthreads();
    if (w0) { const Unit u{M0 / 256, pn}; E.template run<true>(acc, u, 0, wc, fr, fq); }
}

struct PairOrder {
    pg8::StaticOrder S; int pm_off;
    __device__ bool next(int i, Unit& u) const { if (!S.next(i >> 1, u)) return false; if (i & 1) { u.pm += pm_off; u.pn += 4; } return true; }
    __device__ __forceinline__ void a_ready(const Unit&) const {}
    __device__ __forceinline__ void done(const Unit&) const {}
};
constexpr int AO_PM_OFF = (int)((WS_AOB - WS_AOA) / (256 * 512 * 2));
static_assert((WS_AOB - WS_AOA) % (256 * 512 * 2) == 0 && AO_PM_OFF >= 129 && WO_ODIFF - WO_OMLA == 1024 * 512 * 2, "the paired branch projections address AOB / W_o_diff as row tiles behind AOA / W_o_mla");
struct EpiMixPair {
    static constexpr bool PERM = true, AFTER_DRAIN = false;
    bf16_t* MIXIN; const bf16_t* G;
    __device__ __forceinline__ void operator()(AccRef acc, const Unit& u, int wr, int wc, int fr_, int fq_) const {
        const int ln_ = fresh_tid(0), fr = ln_ & 15, fq = ln_ >> 4; (void)fr_; (void)fq_;
        const bool second = u.pn >= 4; const int pm = second ? u.pm - AO_PM_OFF : u.pm, pn = second ? u.pn - 4 : u.pn, goff = second ? 1024 : 0;
        const int row0 = pm * 256 + wr * 64 + fr, colw = pn * 256 + wc * 32 + 8 * fq;
#pragma unroll
        for (int ai = 0; ai < 2; ++ai)
#pragma unroll
            for (int m = 0; m < 4; ++m) { const int row = row0 + ai * 128 + m * 16;
#pragma unroll
                for (int bj = 0; bj < 2; ++bj) { const int col = colw + bj * 128; f32x4 g0, g1; ld8(G + (size_t)row * 2048 + goff + col, g0, g1);
                    f32x4 v0 = acc[ai][bj][m][0] * g0, v1 = acc[ai][bj][m][1] * g1;
                    if (second) { f32x4 p0, p1; ld8(MIXIN + (size_t)row * 1024 + col, p0, p1); v0 = v0 + p0; v1 = v1 + p1; }
                    st8(MIXIN + (size_t)row * 1024 + col, v0, v1); } }
    }
};
template <class Epi> __device__ __forceinline__ void run_gemm_pair(LAS unsigned char* lds, int wave, const bf16_t* A, const bf16_t* Bt, int K, const Epi& E, int pm_off) {
    pg8::Gemm g{A, Bt, M0, 1024, K}; PairOrder S; S.S.init(M0, 1024, launder_s((int)gridDim.x), launder_s((int)blockIdx.x)); S.pm_off = pm_off;
#ifndef NO_GEMM
    pg8::gemm_phase<Epi, PairOrder, true, true>(lds, g, S, E, wave);
#endif
}
#ifndef ONLY_GEMM
#define ONLY_GEMM -1
#endif
#ifndef PROBE_GEMM_MASK
#define PROBE_GEMM_MASK 0
#endif
#ifndef PROBE_GEMM_REP
#define PROBE_GEMM_REP 1
#endif
template <int ID, class Epi> __device__ __forceinline__ void run_gemm1(LAS unsigned char* lds, int wave, int gwave, const bf16_t* A, const bf16_t* Bt, int N, int K, const Epi& E, int Mrows) {
    if (Mrows == MP) mini_gemm(lds, wave, A, Bt, N, K, E);
    pg8::Gemm g{A, Bt, M0, N, K}; pg8::StaticOrder S; S.init(M0, N, launder_s((int)gridDim.x), launder_s((int)blockIdx.x));
#ifndef NO_GEMM
    if constexpr (ONLY_GEMM < 0 || ONLY_GEMM == ID) pg8::gemm_phase<Epi, pg8::StaticOrder, true, true>(lds, g, S, E, wave);
#endif
}
template <int ID, class Epi> __device__ __forceinline__ void run_gemm(LAS unsigned char* lds, int wave, int gwave, const bf16_t* A, const bf16_t* Bt, int N, int K, const Epi& E, int Mrows = MP) {
    for (int r = 0; r < ((PROBE_GEMM_MASK >> ID) & 1 ? PROBE_GEMM_REP : 1); ++r) run_gemm1<ID>(lds, wave, gwave, A, Bt, N, K, E, Mrows);
}

namespace att {
__device__ __forceinline__ float pair_sum_(float v, int lane) { return v + shx(v, 32, lane); }
typedef float f32x16 __attribute__((ext_vector_type(16)));
typedef short s16x4 __attribute__((ext_vector_type(4)));
typedef short v4i16_t __attribute__((ext_vector_type(4)));
typedef LAS const char* lds_cptr;
typedef LAS char* lds_ptr;
#define MFMA32(a, b, c) __builtin_amdgcn_mfma_f32_32x32x16_bf16((a), (b), (c), 0, 0, 0)
__device__ __forceinline__ int crow(int r, int hi) { return (r & 3) + 8 * (r >> 2) + 4 * hi; }
__device__ __forceinline__ s16x4 vtr(lds_cptr p) { return __builtin_bit_cast(s16x4, __builtin_amdgcn_ds_read_tr16_b64_v4i16((LAS v4i16_t*)p)); }
__device__ __forceinline__ bf16x8 pack8(const f32x16& p, int s) {
    u32x4 w; w.x = cvt_pk_bf16(p[8 * s], p[8 * s + 1]); w.y = cvt_pk_bf16(p[8 * s + 2], p[8 * s + 3]); w.z = cvt_pk_bf16(p[8 * s + 4], p[8 * s + 5]); w.w = cvt_pk_bf16(p[8 * s + 6], p[8 * s + 7]);
    return __builtin_bit_cast(bf16x8, w); }

template <int DK, int DV> struct Geo {
    static constexpr int NPK = DK / 8, NPV = DV / 8, KPS = 1024, VPS = 1088, KBYTES = NPK * KPS, VBYTES = NPV * VPS, NSLOT = 3;
};
template <int DK, int DV>
__device__ __forceinline__ void qk_tile(lds_cptr Kb, const bf16x8 (&qf)[DK / 16], int r32, int hi, f32x16& p0, f32x16& p1) {
    typedef Geo<DK, DV> G;
    f32x16 z;
#pragma unroll
    for (int i = 0; i < 16; ++i) z[i] = 0.f;
#pragma unroll
    for (int ds = 0; ds < DK / 16; ++ds) {
        const bf16x8 a0 = *(const LAS bf16x8*)(Kb + (2 * ds + hi) * G::KPS + r32 * 16);
        const bf16x8 a1 = *(const LAS bf16x8*)(Kb + (2 * ds + hi) * G::KPS + (32 + r32) * 16);
        if (ds == 0) { p0 = MFMA32(a0, qf[0], z); p1 = MFMA32(a1, qf[0], z); } else { p0 = MFMA32(a0, qf[ds], p0); p1 = MFMA32(a1, qf[ds], p1); }
    }
}
template <int DV, bool NEGM>
__device__ __forceinline__ void max_rescale(f32x16& p0, f32x16& p1, float& m, float& l, f32x16 (&o)[DV / 32], f32x16& negm, int lane, bool first) {
    float ra = fmaxf(fmaxf(p0[0], p0[1]), p1[0]), rb = fmaxf(fmaxf(p0[2], p0[3]), p1[1]); ra = fmaxf(fmaxf(ra, p1[2]), p1[3]);
#pragma unroll
    for (int i = 4; i < 16; i += 4) { ra = fmaxf(fmaxf(ra, p0[i]), p0[i + 1]); rb = fmaxf(fmaxf(rb, p0[i + 2]), p0[i + 3]); ra = fmaxf(fmaxf(ra, p1[i]), p1[i + 1]); rb = fmaxf(fmaxf(rb, p1[i + 2]), p1[i + 3]); }
    float rm = fmaxf(ra, rb);
    rm = fmaxf(rm, shx(rm, 32, lane));
    if (NEGM) {
        if (first || __builtin_amdgcn_ballot_w64(rm > 8.0f) != 0ull) {
            const float dl = first ? rm : fmaxf(rm, 0.f), alpha = first ? 1.0f : __builtin_amdgcn_exp2f(-dl); m += dl; l *= alpha;
#pragma unroll
            for (int i = 0; i < 16; ++i) { p0[i] -= dl; p1[i] -= dl; negm[i] = -m; }
#pragma unroll
            for (int d0 = 0; d0 < DV / 32; ++d0)
#pragma unroll
                for (int i = 0; i < 16; ++i) o[d0][i] *= alpha;
        }
    } else {
        if (__builtin_amdgcn_ballot_w64(rm > m + 8.0f) != 0ull) {
            const float mn = fmaxf(m, rm), alpha = __builtin_amdgcn_exp2f(m - mn); m = mn; l *= alpha;
#pragma unroll
            for (int d0 = 0; d0 < DV / 32; ++d0)
#pragma unroll
                for (int i = 0; i < 16; ++i) o[d0][i] *= alpha;
        }
    }
}
template <int DK, int DV, bool NEXT, bool NEGM>
__device__ __forceinline__ void fused_step(lds_cptr Kn, lds_cptr Vc, const bf16x8 (&qf)[DK / 16], bf16x8 ka0, bf16x8 ka1, const f32x16& cinit, f32x16& c0, f32x16& c1, f32x16& n0, f32x16& n1, float m, float& l, f32x16 (&o)[DV / 32],
                                           int r32, int hi, int q4, int p4, int blk) {
    typedef Geo<DK, DV> G;
    constexpr int NDS = DK / 16, ND0 = DV / 32;
    const lds_cptr kp = Kn + hi * G::KPS + r32 * 16;
    const lds_cptr vp = Vc + (2 * blk + (p4 >> 1)) * G::VPS + (4 * hi + q4) * 16 + 8 * (p4 & 1);
    bf16x8 ka[2][2]; ka[0][0] = ka0; ka[0][1] = ka1;
    s16x4 vlo[2][ND0], vhi[2][ND0];
#pragma unroll
    for (int ds = 0; ds < NDS; ++ds) {
        if (NEXT && ds + 1 < NDS) { ka[(ds + 1) & 1][0] = *(const LAS bf16x8*)(kp + (ds + 1) * 2 * G::KPS); ka[(ds + 1) & 1][1] = *(const LAS bf16x8*)(kp + (ds + 1) * 2 * G::KPS + 512); }
        if (ds == NDS - 1) {
#pragma unroll
            for (int d0 = 0; d0 < ND0; ++d0) { vlo[0][d0] = vtr(vp + d0 * 4 * G::VPS); vhi[0][d0] = vtr(vp + d0 * 4 * G::VPS + 128); }
        }
        if (NEXT) { if (ds == 0) { n0 = MFMA32(ka[0][0], qf[0], cinit); n1 = MFMA32(ka[0][1], qf[0], cinit); } else { n0 = MFMA32(ka[ds & 1][0], qf[ds], n0); n1 = MFMA32(ka[ds & 1][1], qf[ds], n1); } }
#pragma unroll
        for (int e = (ds * 32) / NDS; e < ((ds + 1) * 32) / NDS; ++e) { if (e < 16) c0[e] = __builtin_amdgcn_exp2f(NEGM ? c0[e] : c0[e] - m); else c1[e - 16] = __builtin_amdgcn_exp2f(NEGM ? c1[e - 16] : c1[e - 16] - m); }
        __builtin_amdgcn_sched_barrier(0);
    }
    float ls = 0.f;
#pragma unroll
    for (int c = 0; c < 4; ++c) {
        if (c + 1 < 4) {
#pragma unroll
            for (int d0 = 0; d0 < ND0; ++d0) { vlo[(c + 1) & 1][d0] = vtr(vp + d0 * 4 * G::VPS + (c + 1) * 256); vhi[(c + 1) & 1][d0] = vtr(vp + d0 * 4 * G::VPS + (c + 1) * 256 + 128); }
        }
        const f32x16& cc = (c >> 1) == 0 ? c0 : c1; const int s = c & 1;
        const bf16x8 pk = pack8(cc, s);
        ls += ((cc[8 * s] + cc[8 * s + 1]) + (cc[8 * s + 2] + cc[8 * s + 3])) + ((cc[8 * s + 4] + cc[8 * s + 5]) + (cc[8 * s + 6] + cc[8 * s + 7]));
#pragma unroll
        for (int d0 = 0; d0 < ND0; ++d0) {
            const bf16x8 vf = __builtin_shufflevector(vlo[c & 1][d0], vhi[c & 1][d0], 0, 1, 2, 3, 4, 5, 6, 7);
            o[d0] = MFMA32(vf, pk, o[d0]);
        }
        __builtin_amdgcn_sched_barrier(0);
    }
    l += ls;
}
template <int DK, int DV>
__device__ __forceinline__ void attn_pass(lds_ptr lds, int wave, const bf16_t* Q, int qpitch, int qrow, const bf16_t* __restrict__ K, int kpitch, const bf16_t* __restrict__ V, int vpitch,
                                          int xrow0, int ntiles, int qlim_meta, int qs, int wave_last_s, f32x16 (&o)[DV / 32], float& linv) {
    typedef Geo<DK, DV> G;
    const int tid = fresh_tid(wave), lane = tid & 63, r32 = lane & 31, hi = lane >> 5;
    bf16x8 qf[DK / 16];
#pragma unroll
    for (int ds = 0; ds < DK / 16; ++ds) qf[ds] = *(const bf16x8*)(Q + (size_t)qrow * qpitch + 16 * ds + 8 * hi);
    constexpr bool NEGM = (DK == 96);
    float m = NEGM ? 0.f : -1e30f, l = 0.f;
    f32x16 negm;
#pragma unroll
    for (int i = 0; i < 16; ++i) negm[i] = 0.f;
#pragma unroll
    for (int d0 = 0; d0 < DV / 32; ++d0)
#pragma unroll
        for (int i = 0; i < 16; ++i) o[d0][i] = 0.f;
    const lds_ptr KB0 = lds, VB0 = lds + G::NSLOT * G::KBYTES;
    const int wv = launder_s(wave);
    constexpr int NKW = (G::NPK + 7) / 8, NVW = (G::NPV + 7) / 8;
    const int nkw = (wv + 8 * (NKW - 1) < G::NPK) ? NKW : NKW - 1, nvw = (wv + 8 * (NVW - 1) < G::NPV) ? NVW : NVW - 1;
#define ATT_GROW(t) ((t) == 0 ? (size_t)M0 : (size_t)xrow0 + 64 * ((t) - 1))
#define ATT_DMAK(t, slot) do { const bf16_t* src_ = K + (ATT_GROW(t) + lane) * kpitch; \
        _Pragma("unroll") for (int i = 0; i < NKW; ++i) { const int c_ = wv + 8 * i; if (c_ < G::NPK) \
            __builtin_amdgcn_global_load_lds((const unsigned*)(src_ + c_ * 8), (LAS unsigned*)(KB0 + (slot) * G::KBYTES + c_ * G::KPS), 16, 0, 0); } } while (0)
#define ATT_DMAV(t, slot) do { const bf16_t* src_ = V + (ATT_GROW(t) + lane) * vpitch; \
        _Pragma("unroll") for (int i = 0; i < NVW; ++i) { const int c_ = wv + 8 * i; if (c_ < G::NPV) \
            __builtin_amdgcn_global_load_lds((const unsigned*)(src_ + c_ * 8), (LAS unsigned*)(VB0 + (slot) * G::VBYTES + c_ * G::VPS), 16, 0, 0); } } while (0)
#define ATT_WAIT_BAR(n) do { const int n_ = (n); \
        if (n_ == 0) asm volatile("s_waitcnt vmcnt(0) lgkmcnt(0)" ::: "memory"); else if (n_ == 1) asm volatile("s_waitcnt vmcnt(1) lgkmcnt(0)" ::: "memory"); \
        else if (n_ == 2) asm volatile("s_waitcnt vmcnt(2) lgkmcnt(0)" ::: "memory"); else if (n_ == 3) asm volatile("s_waitcnt vmcnt(3) lgkmcnt(0)" ::: "memory"); \
        else asm volatile("s_waitcnt vmcnt(4) lgkmcnt(0)" ::: "memory"); \
        __builtin_amdgcn_s_barrier(); asm volatile("" ::: "memory"); } while (0)
#define ATT_ACTIVE(j) ((j) == 0 || 64 * ((j) - 1) <= wave_last_s)
#define ATT_NEEDMASK(j) ((j) == 0 || 64 * ((j) - 1) + 63 > wave_last_s - 31)
    asm volatile("s_waitcnt vmcnt(0)" ::: "memory");
    ATT_DMAK(0, 0); ATT_DMAV(0, 0); if (ntiles > 1) ATT_DMAK(1, 1);
    int late = 0;
    if (ntiles > 1) { ATT_DMAV(1, 1); late += nvw; }
    if (ntiles > 2) { ATT_DMAK(2, 2); late += nkw; }
    ATT_WAIT_BAR(late);
    const int q4 = (lane & 15) >> 2, p4 = lane & 3, blk = (lane >> 4) & 1;
    f32x16 pA0, pA1, pB0, pB1;
    qk_tile<DK, DV>(KB0, qf, r32, hi, pA0, pA1);
    asm volatile("s_waitcnt lgkmcnt(0)" ::: "memory"); __builtin_amdgcn_s_barrier(); asm volatile("" ::: "memory");
    int sk1 = 1, sv0 = 0;
#define ATT_STEP(C0, C1, N0, N1, J) do { const int j_ = (J); int issued_ = 0; \
        if (j_ + 3 < ntiles) { ATT_DMAK(j_ + 3, sk1 == 0 ? 2 : sk1 - 1); issued_ += nkw; } \
        if (j_ + 2 < ntiles) { ATT_DMAV(j_ + 2, sv0 == 0 ? 2 : sv0 - 1); issued_ += nvw; } \
        const lds_cptr Kn_ = KB0 + sk1 * G::KBYTES; const lds_cptr Vc_ = VB0 + sv0 * G::VBYTES; \
        if (j_ < ntiles && ATT_ACTIVE(j_)) { \
              \
            const bf16x8 ka0_ = *(const LAS bf16x8*)(Kn_ + hi * G::KPS + r32 * 16), ka1_ = *(const LAS bf16x8*)(Kn_ + hi * G::KPS + (32 + r32) * 16); \
            if (ATT_NEEDMASK(j_)) { const int kvbase = (j_ == 0) ? 0 : 64 * (j_ - 1); const int qlim = (j_ == 0) ? qlim_meta : qs; \
                _Pragma("unroll") for (int i = 0; i < 16; ++i) { const int kv = kvbase + crow(i, hi); if (kv > qlim) C0[i] = -1e30f; if (kv + 32 > qlim) C1[i] = -1e30f; } } \
            max_rescale<DV, NEGM>(C0, C1, m, l, o, negm, lane, j_ == 0); \
            fused_step<DK, DV, true, NEGM>(Kn_, Vc_, qf, ka0_, ka1_, negm, C0, C1, N0, N1, m, l, o, r32, hi, q4, p4, blk); \
        } \
        sk1 = sk1 == 2 ? 0 : sk1 + 1; sv0 = sv0 == 2 ? 0 : sv0 + 1; \
        ATT_WAIT_BAR(issued_); } while (0)
    for (int j = 0; j < ntiles; j += 2) { ATT_STEP(pA0, pA1, pB0, pB1, j); ATT_STEP(pB0, pB1, pA0, pA1, j + 1); }
    asm volatile("s_waitcnt vmcnt(0)" ::: "memory");
#undef ATT_STEP
#undef ATT_GROW
#undef ATT_DMAK
#undef ATT_DMAV
#undef ATT_WAIT_BAR
#undef ATT_ACTIVE
#undef ATT_NEEDMASK
    l += shx(l, 32, lane);
    linv = 1.0f / l;
}

constexpr int LDS_NEED = 3 * ((Geo<64, 128>::KBYTES + Geo<64, 128>::VBYTES) > (Geo<96, 64>::KBYTES + Geo<96, 64>::VBYTES) ? (Geo<64, 128>::KBYTES + Geo<64, 128>::VBYTES) : (Geo<96, 64>::KBYTES + Geo<96, 64>::VBYTES));

struct Tensors { const bf16_t *QA, *KA, *VA, *QD, *KD, *VD; bf16_t *AOA, *AOB; const float* subln; float lam, lam_init; float* o1scr; };

__device__ __forceinline__ void mla_unit(lds_ptr lds, int wave, const Tensors& T, int b, int h, int qb, bool isx) {
    const int tid = fresh_tid(wave), lane = tid & 63, r32 = lane & 31, hi = lane >> 5, w = wave;
    int qrow, qs, qlim_meta, wave_last_s, ntiles, xrow0 = b * SEQ;
    if (isx) { qs = 256 * qb + 32 * w + r32; qrow = xrow0 + qs; qlim_meta = 15; wave_last_s = 256 * qb + 32 * w + 31; ntiles = 1 + 4 * (qb + 1); }
    else { qs = -1; qrow = M0 + 32 * w + r32; qlim_meta = r32 < 15 ? r32 : 15; wave_last_s = -1; ntiles = 1; if (w > 0) qlim_meta = 15; }
    f32x16 o[2]; float linv;
    attn_pass<96, 64>(lds, wave, T.QA + h * 96, 768, qrow, T.KA + h * 96, 768, T.VA + h * 64, 512, xrow0, ntiles, qlim_meta, qs, wave_last_s, o, linv);
    bf16_t* dst = T.AOA + (size_t)qrow * 512 + h * 64 + 4 * hi;
#pragma unroll
    for (int d0 = 0; d0 < 2; ++d0)
#pragma unroll
        for (int g = 0; g < 4; ++g) {
            uint2 wv; wv.x = cvt_pk_bf16(o[d0][4 * g] * linv, o[d0][4 * g + 1] * linv); wv.y = cvt_pk_bf16(o[d0][4 * g + 2] * linv, o[d0][4 * g + 3] * linv);
            *(uint2*)(dst + 32 * d0 + 8 * g) = wv; }
}
__device__ __forceinline__ void mla_unit64(lds_ptr lds, int wave, const Tensors& T, int b, int h, int qb8) {
    typedef Geo<96, 64> G; constexpr int NDS = 6, ND0 = 2;
    const int tid = fresh_tid(wave), lane = tid & 63, r32 = lane & 31, hi = lane >> 5;
    const int wv = launder_s(wave);
    const int xrow0 = b * SEQ, slab = 512 * qb8 + 64 * wv, sA = slab + r32, sB = sA + 32;
    const int ntiles = 1 + 8 * (qb8 + 1), last_active = 8 * qb8 + wv + 1;
    const bf16_t* Q = T.QA + h * 96; const bf16_t* __restrict__ K = T.KA + h * 96; const bf16_t* __restrict__ V = T.VA + h * 64;
    constexpr int kpitch = 768, vpitch = 512;
    bf16x8 qA[NDS], qB[NDS];
#pragma unroll
    for (int ds = 0; ds < NDS; ++ds) { qA[ds] = *(const bf16x8*)(Q + (size_t)(xrow0 + sA) * 768 + 16 * ds + 8 * hi); qB[ds] = *(const bf16x8*)(Q + (size_t)(xrow0 + sB) * 768 + 16 * ds + 8 * hi); }
    float mA = -1e30f, mB = -1e30f, lA = 0.f, lB = 0.f;
    f32x16 oA[ND0], oB[ND0], nz;
#pragma unroll
    for (int i = 0; i < 16; ++i) { oA[0][i] = 0.f; oA[1][i] = 0.f; oB[0][i] = 0.f; oB[1][i] = 0.f; nz[i] = 0.f; }
    const lds_ptr KB0 = lds, VB0 = lds + G::NSLOT * G::KBYTES;
    constexpr int NKW = (G::NPK + 7) / 8, NVW = (G::NPV + 7) / 8;
    const int nkw = (wv + 8 * (NKW - 1) < G::NPK) ? NKW : NKW - 1, nvw = (wv + 8 * (NVW - 1) < G::NPV) ? NVW : NVW - 1;
#define U64_GROW(t) ((t) == 0 ? (size_t)M0 : (size_t)xrow0 + 64 * ((t) - 1))
#define U64_DMAK(t, slot) do { const bf16_t* src_ = K + (U64_GROW(t) + lane) * kpitch; \
        _Pragma("unroll") for (int i = 0; i < NKW; ++i) { const int c_ = wv + 8 * i; if (c_ < G::NPK) \
            __builtin_amdgcn_global_load_lds((const unsigned*)(src_ + c_ * 8), (LAS unsigned*)(KB0 + (slot) * G::KBYTES + c_ * G::KPS), 16, 0, 0); } } while (0)
#define U64_DMAV(t, slot) do { const bf16_t* src_ = V + (U64_GROW(t) + lane) * vpitch; \
        _Pragma("unroll") for (int i = 0; i < NVW; ++i) { const int c_ = wv + 8 * i; if (c_ < G::NPV) \
            __builtin_amdgcn_global_load_lds((const unsigned*)(src_ + c_ * 8), (LAS unsigned*)(VB0 + (slot) * G::VBYTES + c_ * G::VPS), 16, 0, 0); } } while (0)
#define U64_WAIT_BAR(n) do { const int n_ = (n); \
        if (n_ == 0) asm volatile("s_waitcnt vmcnt(0) lgkmcnt(0)" ::: "memory"); else if (n_ == 1) asm volatile("s_waitcnt vmcnt(1) lgkmcnt(0)" ::: "memory"); \
        else if (n_ == 2) asm volatile("s_waitcnt vmcnt(2) lgkmcnt(0)" ::: "memory"); else if (n_ == 3) asm volatile("s_waitcnt vmcnt(3) lgkmcnt(0)" ::: "memory"); \
        else asm volatile("s_waitcnt vmcnt(4) lgkmcnt(0)" ::: "memory"); \
        __builtin_amdgcn_s_barrier(); asm volatile("" ::: "memory"); } while (0)
    asm volatile("s_waitcnt vmcnt(0)" ::: "memory");
    U64_DMAK(0, 0); U64_DMAV(0, 0);
    U64_DMAK(1, 1); U64_DMAV(1, 1);
    U64_WAIT_BAR(nkw + nvw);
    const int q4 = (lane & 15) >> 2, p4 = lane & 3, blk = (lane >> 4) & 1;
    int sk = 0;
    for (int j = 0; j < ntiles; ++j) {
        int issued = 0;
        if (j + 2 < ntiles) { const int s2 = sk == 0 ? 2 : sk - 1; U64_DMAK(j + 2, s2); U64_DMAV(j + 2, s2); issued = nkw + nvw; }
        if (j <= last_active) {
            const lds_cptr kp = KB0 + sk * G::KBYTES + hi * G::KPS + r32 * 16;
            const lds_cptr vp = VB0 + sk * G::VBYTES + (2 * blk + (p4 >> 1)) * G::VPS + (4 * hi + q4) * 16 + 8 * (p4 & 1);
            f32x16 a0, a1, b0, b1;
            bf16x8 ka[2][2]; ka[0][0] = *(const LAS bf16x8*)(kp); ka[0][1] = *(const LAS bf16x8*)(kp + 512);
#pragma unroll
            for (int ds = 0; ds < NDS; ++ds) {
                if (ds + 1 < NDS) { ka[(ds + 1) & 1][0] = *(const LAS bf16x8*)(kp + (ds + 1) * 2 * G::KPS); ka[(ds + 1) & 1][1] = *(const LAS bf16x8*)(kp + (ds + 1) * 2 * G::KPS + 512); }
                if (ds == 0) { a0 = MFMA32(ka[0][0], qA[0], nz); a1 = MFMA32(ka[0][1], qA[0], nz); b0 = MFMA32(ka[0][0], qB[0], nz); b1 = MFMA32(ka[0][1], qB[0], nz); }
                else { a0 = MFMA32(ka[ds & 1][0], qA[ds], a0); a1 = MFMA32(ka[ds & 1][1], qA[ds], a1); b0 = MFMA32(ka[ds & 1][0], qB[ds], b0); b1 = MFMA32(ka[ds & 1][1], qB[ds], b1); }
                __builtin_amdgcn_sched_barrier(0);
            }
            if (j == 0 || j == last_active) { const int kvbase = (j == 0) ? 0 : 64 * (j - 1); const int limA = (j == 0) ? 15 : sA, limB = (j == 0) ? 15 : sB;
#pragma unroll
                for (int i = 0; i < 16; ++i) { const int kv = kvbase + crow(i, hi);
                    if (kv > limA) a0[i] = -1e30f; if (kv + 32 > limA) a1[i] = -1e30f; if (kv > limB) b0[i] = -1e30f; if (kv + 32 > limB) b1[i] = -1e30f; } }
            max_rescale<64, false>(a0, a1, mA, lA, oA, nz, lane, false);
            max_rescale<64, false>(b0, b1, mB, lB, oB, nz, lane, false);
            s16x4 vlo[2][ND0], vhi[2][ND0];
#pragma unroll
            for (int d0 = 0; d0 < ND0; ++d0) { vlo[0][d0] = vtr(vp + d0 * 4 * G::VPS); vhi[0][d0] = vtr(vp + d0 * 4 * G::VPS + 128); }
#pragma unroll
            for (int i = 0; i < 16; ++i) { a0[i] = __builtin_amdgcn_exp2f(a0[i] - mA); a1[i] = __builtin_amdgcn_exp2f(a1[i] - mA); b0[i] = __builtin_amdgcn_exp2f(b0[i] - mB); b1[i] = __builtin_amdgcn_exp2f(b1[i] - mB); }
            __builtin_amdgcn_sched_barrier(0);
            float lsA = 0.f, lsB = 0.f;
#pragma unroll
            for (int c = 0; c < 4; ++c) {
                if (c + 1 < 4) {
#pragma unroll
                    for (int d0 = 0; d0 < ND0; ++d0) { vlo[(c + 1) & 1][d0] = vtr(vp + d0 * 4 * G::VPS + (c + 1) * 256); vhi[(c + 1) & 1][d0] = vtr(vp + d0 * 4 * G::VPS + (c + 1) * 256 + 128); }
                }
                const f32x16& ca = (c >> 1) == 0 ? a0 : a1; const f32x16& cb = (c >> 1) == 0 ? b0 : b1; const int s = c & 1;
                const bf16x8 pkA = pack8(ca, s), pkB = pack8(cb, s);
                lsA += ((ca[8 * s] + ca[8 * s + 1]) + (ca[8 * s + 2] + ca[8 * s + 3])) + ((ca[8 * s + 4] + ca[8 * s + 5]) + (ca[8 * s + 6] + ca[8 * s + 7]));
                lsB += ((cb[8 * s] + cb[8 * s + 1]) + (cb[8 * s + 2] + cb[8 * s + 3])) + ((cb[8 * s + 4] + cb[8 * s + 5]) + (cb[8 * s + 6] + cb[8 * s + 7]));
#pragma unroll
                for (int d0 = 0; d0 < ND0; ++d0) {
                    const bf16x8 vf = __builtin_shufflevector(vlo[c & 1][d0], vhi[c & 1][d0], 0, 1, 2, 3, 4, 5, 6, 7);
                    oA[d0] = MFMA32(vf, pkA, oA[d0]); oB[d0] = MFMA32(vf, pkB, oB[d0]);
                }
                __builtin_amdgcn_sched_barrier(0);
            }
            lA += lsA; lB += lsB;
        }
        sk = sk == 2 ? 0 : sk + 1;
        U64_WAIT_BAR(issued);
    }
    asm volatile("s_waitcnt vmcnt(0)" ::: "memory");
#undef U64_GROW
#undef U64_DMAK
#undef U64_DMAV
#undef U64_WAIT_BAR
    const float liA = 1.0f / pair_sum_(lA, lane), liB = 1.0f / pair_sum_(lB, lane);
    bf16_t* dA = T.AOA + (size_t)(xrow0 + sA) * 512 + h * 64 + 4 * hi; bf16_t* dB = T.AOA + (size_t)(xrow0 + sB) * 512 + h * 64 + 4 * hi;
#pragma unroll
    for (int d0 = 0; d0 < 2; ++d0)
#pragma unroll
        for (int g = 0; g < 4; ++g) {
            uint2 wa; wa.x = cvt_pk_bf16(oA[d0][4 * g] * liA, oA[d0][4 * g + 1] * liA); wa.y = cvt_pk_bf16(oA[d0][4 * g + 2] * liA, oA[d0][4 * g + 3] * liA);
            uint2 wb; wb.x = cvt_pk_bf16(oB[d0][4 * g] * liB, oB[d0][4 * g + 1] * liB); wb.y = cvt_pk_bf16(oB[d0][4 * g + 2] * liB, oB[d0][4 * g + 3] * liB);
            *(uint2*)(dA + 32 * d0 + 8 * g) = wa; *(uint2*)(dB + 32 * d0 + 8 * g) = wb; }
}
__device__ __forceinline__ void diff_unit(lds_ptr lds, int wave, const Tensors& T, int b, int h, int qb, bool isx) {
    const int tid = fresh_tid(wave), lane = tid & 63, r32 = lane & 31, hi = lane >> 5, w = wave;
    int qrow, qs, qlim_meta, wave_last_s, ntiles, xrow0 = b * SEQ;
    if (isx) { qs = 256 * qb + 32 * w + r32; qrow = xrow0 + qs; qlim_meta = 15; wave_last_s = 256 * qb + 32 * w + 31; ntiles = 1 + 4 * (qb + 1); }
    else { qs = -1; qrow = M0 + 32 * w + r32; qlim_meta = r32 < 15 ? r32 : 15; wave_last_s = -1; ntiles = 1; if (w > 0) qlim_meta = 15; }
    f32x16 o2[4]; float linv2;
    f32x4* sp = (f32x4*)(T.o1scr) + tid;
    {
        f32x16 o1[4]; float linv1;
        attn_pass<64, 128>(lds, wave, T.QD + (2 * h) * 64, 512, qrow, T.KD + (2 * h) * 64, 512, T.VD + h * 128, 512, xrow0, ntiles, qlim_meta, qs, wave_last_s, o1, linv1);
#pragma unroll
        for (int d0 = 0; d0 < 4; ++d0)
#pragma unroll
            for (int g = 0; g < 4; ++g) sp[(d0 * 4 + g) * 512] = (f32x4){o1[d0][4 * g] * linv1, o1[d0][4 * g + 1] * linv1, o1[d0][4 * g + 2] * linv1, o1[d0][4 * g + 3] * linv1};
    }
    attn_pass<64, 128>(lds, wave, T.QD + (2 * h + 1) * 64, 512, qrow, T.KD + (2 * h + 1) * 64, 512, T.VD + h * 128, 512, xrow0, ntiles, qlim_meta, qs, wave_last_s, o2, linv2);
    const float lam2 = T.lam * linv2; float ss = 0.f;
    f32x16 o1[4];
#pragma unroll
    for (int d0 = 0; d0 < 4; ++d0)
#pragma unroll
        for (int g = 0; g < 4; ++g) { const f32x4 t = sp[(d0 * 4 + g) * 512]; o1[d0][4 * g] = t[0]; o1[d0][4 * g + 1] = t[1]; o1[d0][4 * g + 2] = t[2]; o1[d0][4 * g + 3] = t[3]; }
#pragma unroll
    for (int d0 = 0; d0 < 4; ++d0)
#pragma unroll
        for (int i = 0; i < 16; ++i) { const float d = o1[d0][i] - lam2 * o2[d0][i]; o1[d0][i] = d; ss += d * d; }
    ss += shx(ss, 32, lane);
    const float rs = rsqrtf(ss * (1.0f / 128.0f) + EPS) * (1.0f - T.lam_init);
    bf16_t* dst = T.AOB + (size_t)qrow * 512 + h * 128 + 4 * hi;
#pragma unroll
    for (int d0 = 0; d0 < 4; ++d0)
#pragma unroll
        for (int g = 0; g < 4; ++g) { const f32x4 sg = *(const f32x4*)(T.subln + 32 * d0 + 8 * g + 4 * hi);
            uint2 wv; wv.x = cvt_pk_bf16(o1[d0][4 * g] * rs * sg[0], o1[d0][4 * g + 1] * rs * sg[1]); wv.y = cvt_pk_bf16(o1[d0][4 * g + 2] * rs * sg[2], o1[d0][4 * g + 3] * rs * sg[3]);
            *(uint2*)(dst + 32 * d0 + 8 * g) = wv; }
}
__device__ __forceinline__ void attn_phase(lds_ptr lds, int wave, const Tensors& T, int vcu_, int G_) {
    const int vcu = launder_s(vcu_), G = launder_s(G_);
    for (int v = vcu; v < 256; v += G) {
        { const int bh = v >> 3, s = v & 7;
#ifndef NO_DIFF
          diff_unit(lds, wave, T, bh >> 2, bh & 3, s, true); diff_unit(lds, wave, T, bh >> 2, bh & 3, 15 - s, true);
#endif
        }
        { const int bh = v >> 2, s = v & 3;
#ifndef NO_MLA
          mla_unit64(lds, wave, T, bh >> 3, bh & 7, s); mla_unit64(lds, wave, T, bh >> 3, bh & 7, 7 - s);
#endif
        }
#ifndef NO_MLA
        if (v < 8) mla_unit(lds, wave, T, 0, v, 0, false);
#endif
#ifndef NO_DIFF
        if (v >= 8 && v < 12) diff_unit(lds, wave, T, 0, v - 8, 0, false);
#endif
    }
}
}

#define XB_TMO      128
#define XB_XCNT(j)  (256  + 64 * (j))
#define XB_XSUB(j)  (1280 + 64 * (j))
#define XB_XGEN(j)  (2304 + 64 * (j))
#define XB_TOP      3328
#define XB_TOPGEN   3392
#define XCD_BAR_WORDS 3456
#define XB_SPIN_CAP (1u << 18)

__device__ __forceinline__ unsigned xb_ld(unsigned* p)              { return __hip_atomic_load(p, __ATOMIC_RELAXED, __HIP_MEMORY_SCOPE_AGENT); }
__device__ __forceinline__ unsigned xb_add(unsigned* p, unsigned v) { return __hip_atomic_fetch_add(p, v, __ATOMIC_RELAXED, __HIP_MEMORY_SCOPE_AGENT); }
__device__ __forceinline__ unsigned xb_xcc_id() { return (unsigned)__builtin_amdgcn_s_getreg((3 << 11) | 20) & 0xFu; }
#define XB_SPIN(cond, bar) do { unsigned _sp = 0; while (cond) { __builtin_amdgcn_s_sleep(1); \
    if ((++_sp & 255u) == 0u) { if (xb_ld(&(bar)[XB_TMO])) break; if (_sp > XB_SPIN_CAP) { atomicAdd(&(bar)[XB_TMO], 1u); break; } } } } while (0)

struct XcdBarrier { unsigned* bar; unsigned x; volatile LAS unsigned* st; };
__device__ __forceinline__ XcdBarrier xcd_barrier_post(unsigned* bar, volatile LAS unsigned* st, int tid) {
    XcdBarrier b; b.bar = bar; b.x = xb_xcc_id(); b.st = st;
    if (tid == 0) (void)xb_add(&bar[XB_XCNT(b.x)], 1u);
    return b;
}
__device__ __forceinline__ void xcd_barrier_complete(unsigned* bar, unsigned x, unsigned& nloc, unsigned& nx) {
    const unsigned G = gridDim.x * gridDim.y * gridDim.z;
    unsigned sum, cnt, mine, sp = 0u;
    for (;;) {
        sum = 0u; cnt = 0u; mine = 0u;
#pragma unroll
        for (unsigned j = 0; j < 16; ++j) { const unsigned c = xb_ld(&bar[XB_XCNT(j)]); sum += c; cnt += (c > 0u) ? 1u : 0u; mine = (j == x) ? c : mine; }
        if (sum == G) break;
        __builtin_amdgcn_s_sleep(1);
        if ((++sp & 255u) == 0u) { if (xb_ld(&bar[XB_TMO])) break; if (sp > XB_SPIN_CAP) { atomicAdd(&bar[XB_TMO], 1u); break; } }
    }
    nloc = mine > 0u ? mine : 1u; nx = cnt > 0u ? cnt : 1u;
}

__device__ __forceinline__ void xcd_barrier(const XcdBarrier& b, int tid) {
    asm volatile("s_waitcnt vmcnt(0)" ::: "memory");
    __syncthreads();
    if (tid == 0) {
        unsigned* bar = b.bar;
        __builtin_amdgcn_s_waitcnt(0);
        unsigned nloc = b.st[0], nx = b.st[1];
        if (nloc == 0u) { xcd_barrier_complete(bar, b.x, nloc, nx); b.st[0] = nloc; b.st[1] = nx; }
        const unsigned old = xb_add(&bar[XB_XSUB(b.x)], 1u);
        const unsigned gen = old / nloc;
        if (old + 1u == (gen + 1u) * nloc) {
            __builtin_amdgcn_fence(__ATOMIC_RELEASE, "agent");
            asm volatile("s_waitcnt vmcnt(0)" ::: "memory");
            const unsigned og = xb_add(&bar[XB_TOP], 1u);
            const unsigned tg = og / nx;
            if (og + 1u == (tg + 1u) * nx) xb_add(&bar[XB_TOPGEN], 1u);
            else XB_SPIN(xb_ld(&bar[XB_TOPGEN]) == tg, bar);
            __builtin_amdgcn_fence(__ATOMIC_ACQUIRE, "agent");
            xb_add(&bar[XB_XGEN(b.x)], 1u);
            asm volatile("s_waitcnt vmcnt(0)" ::: "memory");
        } else {
            XB_SPIN(xb_ld(&bar[XB_XGEN(b.x)]) == gen, bar);
            __builtin_amdgcn_fence(__ATOMIC_ACQUIRE, "agent");
            asm volatile("s_waitcnt vmcnt(0)" ::: "memory");
        }
    }
    __syncthreads();
}

enum { WK_ID = 0, WK_INA, WK_INB, WK_UQ, WK_UKV, WK_GU };
__device__ __forceinline__ int src_col(int kind, int n) {
    switch (kind) {
    case WK_INA: {
        if (n < 1024) { const int seg = n >> 9, g = (n & 511) >> 6, j = n & 63; const int t = j < 16 ? ((j & 1) ? 8 + (j >> 1) : (j >> 1)) : j; return (seg == 0 ? 672 : 1184) + 64 * g + t; }
        if (n < 1536) return 1696 + (n - 1024);
        if (n < 1792) return 384 + (n - 1536);
        if (n < 2176) return n - 1792;
        if (n < 2208) { const int j = n - 2176; return 640 + ((j & 1) ? 16 + (j >> 1) : (j >> 1)); }
        return -1; }
    case WK_INB: return 2208 + n;
    case WK_UQ: { const int hd = n / 96, j = n % 96; if (j < 64) return n; const int jj = j - 64; return hd * 96 + 64 + ((jj & 1) ? 16 + (jj >> 1) : (jj >> 1)); }
    case WK_UKV: { if (n < 512) return (n >> 6) * 128 + (n & 63); const int nn = n - 512; return (nn >> 6) * 128 + 64 + (nn & 63); }
    case WK_GU: { const int t = n >> 8, c = n & 255; return c < 128 ? 128 * t + c : DFF + 128 * t + (c - 128); }
    default: return n;
    }
}
__device__ __forceinline__ void transpose_item(const float* __restrict__ W, int K, int N, const float* __restrict__ gain, bf16_t* WT, int kind, LAS float* scr, int item, int lane) {
    const int kblk = K / 64, nb = item / kblk, kb = item % kblk, k0 = 64 * kb, n0 = 32 * nb;
    const int s0 = src_col(kind, n0), base = s0 & ~31;
    f32x4 v[8];
    const int c4 = lane & 7, kr = lane >> 3;
    if (s0 >= 0) {
#pragma unroll
        for (int i = 0; i < 8; ++i) v[i] = *(const f32x4*)(W + (size_t)(k0 + kr + 8 * i) * N + base + 4 * c4);
        if (gain) {
#pragma unroll
            for (int i = 0; i < 8; ++i) v[i] = v[i] * gain[k0 + kr + 8 * i];
        }
    } else {
#pragma unroll
        for (int i = 0; i < 8; ++i) v[i] = (f32x4){0.f, 0.f, 0.f, 0.f};
    }
#pragma unroll
    for (int i = 0; i < 8; ++i) { LAS float* d = scr + (kr + 8 * i) * 33 + 4 * c4; d[0] = v[i][0]; d[1] = v[i][1]; d[2] = v[i][2]; d[3] = v[i][3]; }
    asm volatile("s_waitcnt lgkmcnt(0)" ::: "memory");
    const int c = lane & 7;
#pragma unroll
    for (int j = 0; j < 4; ++j) { const int n = (lane >> 3) + 8 * j; const int sc = s0 >= 0 ? src_col(kind, n0 + n) - base : n; const LAS float* s = scr + (8 * c) * 33 + sc;
        u32x4 o; o.x = pk2(s[0 * 33], s[1 * 33]); o.y = pk2(s[2 * 33], s[3 * 33]); o.z = pk2(s[4 * 33], s[5 * 33]); o.w = pk2(s[6 * 33], s[7 * 33]);
        *(u32x4*)(WT + (size_t)(n0 + n) * K + k0 + 8 * c) = o; }
    asm volatile("s_waitcnt lgkmcnt(0)" ::: "memory");
}
struct WDesc { int in_idx, K, N, Np, kind, gain_idx; size_t off; };
__device__ __forceinline__ WDesc wdesc(int i) {
    switch (i) {
    case 0: return WDesc{I_WIN, 1024, 4256, 2304, WK_INA, -1, WO_INA};
    case 1: return WDesc{I_WIN, 1024, 4256, 2048, WK_INB, -1, WO_INB};
    case 2: return WDesc{I_WUQ, 384, 768, 768, WK_UQ, I_QNORM, WO_UQ};
    case 3: return WDesc{I_WUKV, 256, 1024, 1024, WK_UKV, I_KVNORM, WO_UKV};
    case 4: return WDesc{I_WOMLA, 512, 1024, 1024, WK_ID, -1, WO_OMLA};
    case 5: return WDesc{I_WODIFF, 512, 1024, 1024, WK_ID, -1, WO_ODIFF};
    case 6: return WDesc{I_WOUT, 1024, 1024, 1024, WK_ID, -1, WO_OUT};
    case 7: return WDesc{I_WGU, 1024, 5632, 5632, WK_GU, -1, WO_GU};
    default: return WDesc{I_WDOWN, 2816, 1024, 1024, WK_ID, -1, WO_DOWN};
    }
}
__device__ __forceinline__ void wave_sum4(float (&s)[4], int lane) {
#pragma unroll
    for (int o = 1; o < 64; o <<= 1) {
        float t[4];
#pragma unroll
        for (int r = 0; r < 4; ++r) t[r] = shx(s[r], o, lane);
#pragma unroll
        for (int r = 0; r < 4; ++r) s[r] += t[r];
    }
}
__device__ __forceinline__ void row_pass(int gw_, int ngw_, int wave_, int nrows, const float* rin_x, const float* rin_m, const bf16_t* mix, const float* gpost, float* rout_x, float* rout_m, const float* gnext, bf16_t* XN) {
    const int lane = fresh_tid(wave_) & 63; const int gw = launder_s(gw_), ngw = launder_s(ngw_);
    static_assert(M0 % 4 == 0 && MVALID % 4 == 0 && MP % 4 == 0, "row groups of 4 never straddle a buffer boundary");
    for (int g = gw; g < nrows / 4; g += ngw) {
        const int row0 = 4 * g;
        if (row0 >= MVALID) { if (XN) {
#pragma unroll
                for (int r = 0; r < 4; ++r) { unsigned long long* o8 = (unsigned long long*)(XN + (size_t)(row0 + r) * DM) + lane;
#pragma unroll
                    for (int j = 0; j < 4; ++j) o8[64 * j] = 0ull; } } continue; }
        const float* rp = row0 < M0 ? rin_x + (size_t)row0 * DM : rin_m + (size_t)(row0 - M0) * DM;
        f32x4 v[4][4];
#pragma unroll
        for (int r = 0; r < 4; ++r)
#pragma unroll
            for (int j = 0; j < 4; ++j) v[r][j] = ((const f32x4*)(rp + (size_t)r * DM))[lane + 64 * j];
        if (mix) {
            uint2 mw[4][4];
#pragma unroll
            for (int r = 0; r < 4; ++r)
#pragma unroll
                for (int j = 0; j < 4; ++j) mw[r][j] = ((const uint2*)(mix + (size_t)(row0 + r) * DM))[lane + 64 * j];
            f32x4 gp[4];
#pragma unroll
            for (int j = 0; j < 4; ++j) gp[j] = ((const f32x4*)gpost)[lane + 64 * j];
            float s[4];
#pragma unroll
            for (int r = 0; r < 4; ++r) { s[r] = 0.f;
#pragma unroll
                for (int j = 0; j < 4; ++j) { const f32x4 m4 = (f32x4){bflo(mw[r][j].x), bfhi(mw[r][j].x), bflo(mw[r][j].y), bfhi(mw[r][j].y)}; s[r] += sumsq4(m4); } }
            wave_sum4(s, lane);
#pragma unroll
            for (int r = 0; r < 4; ++r) { const float rs = rsqrtf(s[r] * (1.0f / DM) + EPS);
#pragma unroll
                for (int j = 0; j < 4; ++j) { const f32x4 m4 = (f32x4){bflo(mw[r][j].x), bfhi(mw[r][j].x), bflo(mw[r][j].y), bfhi(mw[r][j].y)}; v[r][j] = v[r][j] + m4 * rs * gp[j]; } }
        }
        if (rout_x) { float* op = row0 < M0 ? rout_x + (size_t)row0 * DM : rout_m + (size_t)(row0 - M0) * DM;
#pragma unroll
            for (int r = 0; r < 4; ++r)
#pragma unroll
                for (int j = 0; j < 4; ++j) ((f32x4*)(op + (size_t)r * DM))[lane + 64 * j] = v[r][j]; }
        if (XN) { float s[4];
#pragma unroll
            for (int r = 0; r < 4; ++r) { s[r] = 0.f;
#pragma unroll
                for (int j = 0; j < 4; ++j) s[r] += sumsq4(v[r][j]); }
            wave_sum4(s, lane);
            f32x4 gn[4];
#pragma unroll
            for (int j = 0; j < 4; ++j) gn[j] = ((const f32x4*)gnext)[lane + 64 * j];
#pragma unroll
            for (int r = 0; r < 4; ++r) { const float rs = rsqrtf(s[r] * (1.0f / DM) + EPS); unsigned long long* o8 = (unsigned long long*)(XN + (size_t)(row0 + r) * DM) + lane;
#pragma unroll
                for (int j = 0; j < 4; ++j) { const f32x4 y = v[r][j] * rs * gn[j];
                    o8[64 * j] = (unsigned long long)cvt_pk_bf16(y[0], y[1]) | ((unsigned long long)cvt_pk_bf16(y[2], y[3]) << 32); } } }
    }
}

constexpr int LDS_BYTES = 131072 + 1024;
static_assert(att::LDS_NEED <= 131072, "attention LDS");
__global__ void __launch_bounds__(512, 2) fwd_megakernel(Params p) {
    extern __shared__ __attribute__((aligned(16))) unsigned char lds_raw[];
    LAS unsigned char* lds = (LAS unsigned char*)lds_raw;
    cg::grid_group grid = cg::this_grid();
    const int wave = __builtin_amdgcn_readfirstlane((int)threadIdx.x >> 6);
    const int G = gridDim.x, bx = blockIdx.x, vcu = (G % 8 == 0) ? (bx % 8) * (G / 8) + bx / 8 : bx;
    const int gw = vcu * 8 + wave, ngw = G * 8;
    { const int t0 = fresh_tid(wave); if (t0 < 64) ((LAS unsigned*)(lds + 131072))[t0] = 0u; __syncthreads(); }
    XcdBarrier xbar; xbar.bar = (unsigned*)(p.ws + WS_BAR); xbar.x = xb_xcc_id(); xbar.st = (volatile LAS unsigned*)(lds + 131072 + 32);
#define GRID_BAR() xcd_barrier(xbar, fresh_tid(wave))
#define WSP() ({ unsigned char* w__ = p.ws; asm volatile("" : "+s"(w__)); w__; })
#define B16(w, off) ((bf16_t*)((w) + (off)))
    {
        unsigned char* ws = WSP();
        float* lamp = (float*)(ws + WS_LAM); float* rope = (float*)(ws + WS_ROPE);
        LAS float* scr = (LAS float*)(lds + wave * 16384);
        const int tid = fresh_tid(wave), lane = tid & 63;
        for (int L = 0; L < NLAYER; ++L)
            for (int wi = 0; wi < 9; ++wi) {
                const WDesc d = wdesc(wi);
                const float* W = p.in[d.in_idx] + (size_t)L * d.K * d.N;
                const float* gain = d.gain_idx >= 0 ? p.in[d.gain_idx] + (size_t)L * d.K : nullptr;
                bf16_t* WT = (bf16_t*)(ws + WS_W + L * WS_WSTRIDE + d.off);
                const int nitems = (d.Np / 32) * (d.K / 64);
                for (int it = gw; it < nitems; it += ngw) transpose_item(W, d.K, d.N, gain, WT, d.kind, scr, it, lane);
            }
        for (int i = bx * 512 + tid; i < NPOS * 24; i += G * 512) { const int pos = i / 24, f = i % 24; const double rev = (double)pos * p.invrev[f]; const float fr = (float)(rev - floor(rev));
            rope[2 * i] = __builtin_amdgcn_cosf(fr); rope[2 * i + 1] = __builtin_amdgcn_sinf(fr); }
        if (launder_s(bx) == 0) { unsigned* bw = (unsigned*)(ws + WS_BAR); for (int i = tid; i < XCD_BAR_WORDS; i += 512) bw[i] = 0u; }
        if (launder_s(bx) == 0 && launder_s(wave) == 0) {
            for (int L = 0; L < NLAYER; ++L) { const float* lp = p.in[I_LAMBDA] + L * 256;
                const float a = wave_sum(lp[lane] * lp[64 + lane], lane), b = wave_sum(lp[128 + lane] * lp[192 + lane], lane);
                const float lam_init = L == 0 ? 0.2f : 0.35550906759096924f;
                if (lane == 0) lamp[L] = expf(a) - expf(b) + lam_init; }
        }
        row_pass(gw, ngw, wave, MP, p.in[I_X], p.in[I_META], nullptr, nullptr, nullptr, nullptr, p.in[I_NMIXPRE], B16(ws, WS_XN));
    }
    grid.sync();
    if (fresh_tid(wave) == 0) (void)xb_add(&xbar.bar[XB_XCNT(xbar.x)], 1u);

    for (int L = 0; L < NLAYER; ++L) {
        const size_t wlo = WS_W + L * WS_WSTRIDE;
        const size_t sqo = WS_SSQQ, skvo = WS_SSQKV;
        const int Mpost = (L + 1 < NLAYER) ? MP : M0;
        { unsigned char* ws = WSP();
          EpiInA E{B16(ws, WS_QD), B16(ws, WS_KD), B16(ws, WS_VD), B16(ws, WS_KVL), B16(ws, WS_QL), B16(ws, WS_KA), (float*)(ws + sqo), (float*)(ws + skvo), (const float*)(ws + WS_ROPE)};
          run_gemm<0>(lds, wave, gw, B16(ws, WS_XN), B16(ws, wlo + WO_INA), 2304, 1024, E); }
        GRID_BAR();
        { unsigned char* ws = WSP(); EpiQA E{B16(ws, WS_QA), (const float*)(ws + sqo), (const float*)(ws + WS_ROPE)}; run_gemm<1>(lds, wave, gw, B16(ws, WS_QL), B16(ws, wlo + WO_UQ), 768, 384, E); }
        { unsigned char* ws = WSP(); EpiKV E{B16(ws, WS_KA), B16(ws, WS_VA), (const float*)(ws + skvo)}; run_gemm<2>(lds, wave, gw, B16(ws, WS_KVL), B16(ws, wlo + WO_UKV), 1024, 256, E); }
        GRID_BAR();
        { unsigned char* ws = WSP();
          att::Tensors T{B16(ws, WS_QA), B16(ws, WS_KA), B16(ws, WS_VA), B16(ws, WS_QD), B16(ws, WS_KD), B16(ws, WS_VD), B16(ws, WS_AOA), B16(ws, WS_AOB), p.in[I_SUBLN] + L * 128, ((const float*)(ws + WS_LAM))[L], L == 0 ? 0.2f : 0.35550906759096924f, (float*)(ws + WS_O1 + (size_t)bx * 131072)};
          att::attn_phase((att::lds_ptr)lds, wave, T, vcu, G);
#ifdef PROBE_ATT2
          att::attn_phase((att::lds_ptr)lds, wave, T, vcu, G);
#endif
        }
        GRID_BAR();
        if (Mpost == MP) {
            { unsigned char* ws = WSP(); EpiGate E{B16(ws, WS_G), 0}; mini_gemm(lds, wave, B16(ws, WS_XN), B16(ws, wlo + WO_INB), 1024, 1024, E); }
            { unsigned char* ws = WSP(); EpiGate E{B16(ws, WS_G), 1024}; mini_gemm(lds, wave, B16(ws, WS_XN), B16(ws, wlo + WO_INB) + (size_t)1024 * 1024, 1024, 1024, E); }
            { unsigned char* ws = WSP(); EpiMix<false> E{B16(ws, WS_MIXIN), B16(ws, WS_G), 0}; mini_gemm(lds, wave, B16(ws, WS_AOA), B16(ws, wlo + WO_OMLA), 1024, 512, E); }
            { unsigned char* ws = WSP(); EpiMix<true> E{B16(ws, WS_MIXIN), B16(ws, WS_G), 1024}; mini_gemm(lds, wave, B16(ws, WS_AOB), B16(ws, wlo + WO_ODIFF), 1024, 512, E); }
        }
        { unsigned char* ws = WSP(); EpiGate E{B16(ws, WS_G), 0}; run_gemm_pair(lds, wave, B16(ws, WS_XN), B16(ws, wlo + WO_INB), 1024, E, 0); }
        { unsigned char* ws = WSP(); EpiMixPair E{B16(ws, WS_MIXIN), B16(ws, WS_G)}; run_gemm_pair(lds, wave, B16(ws, WS_AOA), B16(ws, wlo + WO_OMLA), 512, E, AO_PM_OFF); }
        GRID_BAR();
        { unsigned char* ws = WSP(); EpiPlain E{B16(ws, WS_MIX), 1024}; run_gemm<7>(lds, wave, gw, B16(ws, WS_MIXIN), B16(ws, wlo + WO_OUT), 1024, 1024, E, Mpost); }
        GRID_BAR();
        { unsigned char* ws = WSP(); float* RM = (float*)(ws + WS_RM);
          row_pass(gw, ngw, wave, Mpost, L == 0 ? p.in[I_X] : p.out, L == 0 ? p.in[I_META] : RM, B16(ws, WS_MIX), p.in[I_NMIXPOST] + L * DM, p.out, RM, p.in[I_NFFNPRE] + L * DM, B16(ws, WS_XN)); }
        GRID_BAR();
        { unsigned char* ws = WSP(); EpiSwiglu E{B16(ws, WS_FF)}; run_gemm<8>(lds, wave, gw, B16(ws, WS_XN), B16(ws, wlo + WO_GU), 5632, 1024, E, Mpost); }
        GRID_BAR();
        { unsigned char* ws = WSP(); EpiPlain E{B16(ws, WS_FFO), 1024}; run_gemm<9>(lds, wave, gw, B16(ws, WS_FF), B16(ws, wlo + WO_DOWN), 1024, DFF, E, Mpost); }
        GRID_BAR();
        { unsigned char* ws = WSP(); float* RM = (float*)(ws + WS_RM);
          if (L + 1 < NLAYER) row_pass(gw, ngw, wave, MP, p.out, RM, B16(ws, WS_FFO), p.in[I_NFFNPOST] + L * DM, p.out, RM, p.in[I_NMIXPRE] + (L + 1) * DM, B16(ws, WS_XN));
          else row_pass(gw, ngw, wave, M0, p.out, RM, B16(ws, WS_FFO), p.in[I_NFFNPOST] + L * DM, p.out, RM, nullptr, nullptr); }
        if (L + 1 < NLAYER) GRID_BAR();
    }
}

extern "C" void kernel_launch(void* const* d_in, const int* in_sizes, int n_in, void* d_out, int out_size, void* d_ws, size_t ws_size, hipStream_t stream) {
    static int grid = 0;
    if (grid == 0) {
        if (n_in != 18 || ws_size < WS_END) { fprintf(stderr, "kernel_launch: unexpected n_in %d / ws_size %zu\n", n_in, ws_size); grid = -1; return; }
        int dev = 0, cus = 0, per_cu = 0;
        hipGetDevice(&dev); hipDeviceGetAttribute(&cus, hipDeviceAttributeMultiprocessorCount, dev);
        if (hipFuncSetAttribute((const void*)fwd_megakernel, hipFuncAttributeMaxDynamicSharedMemorySize, LDS_BYTES) != hipSuccess) { fprintf(stderr, "kernel_launch: hipFuncSetAttribute failed\n"); grid = -1; return; }
        if (hipOccupancyMaxActiveBlocksPerMultiprocessor(&per_cu, (const void*)fwd_megakernel, 512, LDS_BYTES) != hipSuccess || per_cu < 1) { fprintf(stderr, "kernel_launch: occupancy query gave %d\n", per_cu); per_cu = 1; }
        (void)hipGetLastError();
        grid = cus < 256 ? cus : 256;
    }
    if (grid < 0) return;
    Params p{};
    for (int i = 0; i < 18; ++i) p.in[i] = (const float*)d_in[i];
    p.out = (float*)d_out; p.ws = (unsigned char*)d_ws;
    const double TWO_PI = 6.283185307179586476925286766559;
    for (int i = 0; i < 16; ++i) p.invrev[i] = pow(500000.0, -(double)i / 16.0) / TWO_PI;
    for (int i = 0; i < 8; ++i) p.invrev[16 + i] = pow(500000.0, -(double)i / 8.0) / TWO_PI;
    void* args[] = {&p};
    hipError_t e = hipLaunchCooperativeKernel((const void*)fwd_megakernel, dim3(grid), dim3(512), args, LDS_BYTES, stream);
    if (e != hipSuccess) fprintf(stderr, "cooperative launch failed: %s (grid %d)\n", hipGetErrorString(e), grid);
}
```

```cpp
#include <hip/hip_runtime.h>
#include <hip/hip_cooperative_groups.h>
#include <cstdio>
#include <cstdint>
#include <cmath>
namespace cg = cooperative_groups;
__device__ __forceinline__ int launder(int x) { asm volatile("" : "+v"(x)); return x; }
__device__ __forceinline__ int launder_s(int x) { asm volatile("" : "+s"(x)); return x; }
__device__ __forceinline__ int fresh_tid(int wave) { int z = 0; asm volatile("" : "+s"(z)); return wave * 64 + (int)__builtin_amdgcn_mbcnt_hi(~0u, __builtin_amdgcn_mbcnt_lo(~0u, (unsigned)z)); }
__device__ __forceinline__ float shx(float v, int o, int lane) { return __builtin_bit_cast(float, __builtin_amdgcn_ds_bpermute((lane ^ o) << 2, __builtin_bit_cast(int, v))); }

namespace pg8 {
#define PG8_LAS __attribute__((address_space(3)))
typedef unsigned short bf16_t;
typedef short bf16x8 __attribute__((ext_vector_type(8)));
typedef float f32x4 __attribute__((ext_vector_type(4)));
typedef unsigned u32x4 __attribute__((ext_vector_type(4)));
constexpr int BM = 256, BK = 64, HALF = 128, HTB = HALF * BK * 2  , STAGE_BYTES = 8 * HTB, NXCD = 8, WGM = 8;

__host__ __device__ __forceinline__ int lds_byte(int r, int c) { const int st = (r >> 4) * 2 + (c >> 5), rr = r & 15, cc = c & 31, ob = rr * 64 + cc * 2; return st * 1024 + (ob ^ (((ob >> 9) & 1) << 5)); }
__host__ __device__ __forceinline__ void stage_rc(int b, int& R, int& C) { const int st = b / 1024, sb = b % 1024, swz = sb ^ (((sb >> 9) & 1) << 5); R = (st >> 1) * 16 + swz / 64; C = (st & 1) * 32 + (swz % 64) / 2; }
__host__ __device__ __forceinline__ int perm32(int rho) { const int n = rho >> 4, i = rho & 15; return 8 * (i >> 2) + 4 * n + (i & 3); }

struct Unit { int pm, pn; };
struct Gemm { const bf16_t* A; const bf16_t* Bt; int M, N, K; };

struct StaticOrder {
    int nM, nN, nwg, G, c;
    __host__ __device__ void init(int M, int N, int G_, int c_) { nM = M / BM; nN = N / BM; nwg = nM * nN; G = G_; c = c_; }
    __host__ __device__ bool next(int i, Unit& u) const {
        const long L = (long)i * G + c; if (L >= nwg) return false;
        int wgid = (int)L; { const int q = nwg / NXCD, r = nwg % NXCD, xcd = wgid % NXCD, off = wgid / NXCD; wgid = (xcd < r ? xcd * (q + 1) : r * (q + 1) + (xcd - r) * q) + off; }
        const int nig = WGM * nN, gid = wgid / nig, fm = gid * WGM, gsz = (nM - fm) < WGM ? (nM - fm) : WGM;
        u.pm = fm + ((wgid % nig) % gsz); u.pn = (wgid % nig) / gsz; return true;
    }
    __device__ __forceinline__ void a_ready(const Unit&) const {}
    __device__ __forceinline__ void done(const Unit&) const {}
};

typedef float f32x2 __attribute__((ext_vector_type(2)));
typedef __bf16 bf16x2_t __attribute__((ext_vector_type(2)));
__device__ __forceinline__ unsigned cvt_pk_bf16(float lo, float hi) { f32x2 v = {lo, hi}; bf16x2_t b = __builtin_convertvector(v, bf16x2_t); return __builtin_bit_cast(unsigned, b); }
template <class Epi, class Sched, bool ALIGN_EPI = false, bool SP2 = false>
__device__ __forceinline__ void gemm_phase(PG8_LAS unsigned char* lds, const Gemm g, const Sched& S, const Epi& E, int wave_) {
    const int tid = fresh_tid(wave_), wid = __builtin_amdgcn_readfirstlane(tid >> 6), lane = tid & 63, wr = wid >> 2, wc = wid & 3, fr = lane & 15, fq = lane >> 4;
    const int K = g.K, nt = K / BK;
    unsigned voffA[2], voffB[2];
#pragma unroll
    for (int i = 0; i < 2; ++i) { int R, C; stage_rc(tid * 16 + i * 8192, R, C); const int Rb = Epi::PERM ? ((R & ~31) + perm32(R & 31)) : R;
        voffA[i] = (unsigned)(R * K + C) * 2u; voffB[i] = (unsigned)(Rb * K + C) * 2u; }
    const size_t kstep = (size_t)(BK * 2);
    const size_t hstep = (size_t)HALF * K * 2;
    const size_t tstep = 2 * hstep;
    const unsigned ldsw = (unsigned)wid * 1024u;
    const int aoff = lds_byte(wr * 64 + fr, fq * 8), boff = lds_byte(wc * 32 + fr, fq * 8);
#define PG8_SA(b, h) (((b) * 2 + (h)) * HTB)
#define PG8_SB(b, h) ((4 + (b) * 2 + (h)) * HTB)
#define PG8_STAGE(bufoff, gbase, voff) do { _Pragma("unroll") for (int _i = 0; _i < 2; ++_i) \
        __builtin_amdgcn_global_load_lds((const unsigned*)((const char*)(gbase) + (voff)[_i]), (PG8_LAS unsigned*)(lds + (bufoff) + ldsw + _i * 8192), 16, 0, 0); } while (0)
#define PG8_LDA(dst, b, h) do { _Pragma("unroll") for (int m = 0; m < 4; ++m) _Pragma("unroll") for (int k = 0; k < 2; ++k) dst[m][k] = *(const PG8_LAS bf16x8*)(lds + PG8_SA(b, h) + aoff + m * 2048 + k * 1024); } while (0)
#define PG8_LDB(dst, b, h) do { _Pragma("unroll") for (int n = 0; n < 2; ++n) _Pragma("unroll") for (int k = 0; k < 2; ++k) dst[n][k] = *(const PG8_LAS bf16x8*)(lds + PG8_SB(b, h) + boff + n * 2048 + k * 1024); } while (0)
#define PG8_MMA(ai, bj, At, Bt) do { __builtin_amdgcn_s_setprio(1); _Pragma("unroll") for (int m = 0; m < 4; ++m) _Pragma("unroll") for (int n = 0; n < 2; ++n) _Pragma("unroll") for (int k = 0; k < 2; ++k) \
        acc[ai][bj][m][n] = __builtin_amdgcn_mfma_f32_16x16x32_bf16(Bt[n][k], At[m][k], acc[ai][bj][m][n], 0, 0, 0); __builtin_amdgcn_s_setprio(0); } while (0)
#define PG8_WAIT_V(n) asm volatile("s_waitcnt vmcnt(" #n ")" ::: "memory")
#define PG8_WAIT_L(n) asm volatile("s_waitcnt lgkmcnt(" #n ")" ::: "memory")
#define PG8_BAR __builtin_amdgcn_s_barrier()
#define PG8_SCHED __builtin_amdgcn_sched_barrier(0)
    Unit cur, nxt; int ui = 0;
    if (!S.next(0, cur)) return;
    f32x4 acc[2][2][4][2];
#pragma unroll
    for (int a = 0; a < 2; ++a)
#pragma unroll
        for (int b = 0; b < 2; ++b)
#pragma unroll
            for (int m = 0; m < 4; ++m)
#pragma unroll
                for (int n = 0; n < 2; ++n) acc[a][b][m][n] = (f32x4){0.f, 0.f, 0.f, 0.f};
    bf16x8 At[4][2], B0[2][2], B1[2][2];
    const char* cA = (const char*)g.A + (size_t)cur.pm * tstep; const char* cB = (const char*)g.Bt + (size_t)cur.pn * tstep;
    S.a_ready(cur);
    if constexpr (SP2) {
        PG8_STAGE(PG8_SB(0, 0), cB, voffB); PG8_STAGE(PG8_SB(0, 1), cB + hstep, voffB); PG8_STAGE(PG8_SA(0, 0), cA, voffA); PG8_STAGE(PG8_SA(0, 1), cA + hstep, voffA);
        if (wr == 1) PG8_BAR;
        PG8_WAIT_V(2); PG8_BAR;
        PG8_STAGE(PG8_SB(1, 0), cB + kstep, voffB); PG8_STAGE(PG8_SA(1, 0), cA + kstep, voffA); PG8_STAGE(PG8_SB(1, 1), cB + hstep + kstep, voffB);
        PG8_WAIT_V(6); PG8_BAR;
    } else {
        PG8_STAGE(PG8_SB(0, 0), cB, voffB); PG8_STAGE(PG8_SA(0, 0), cA, voffA); PG8_STAGE(PG8_SB(0, 1), cB + hstep, voffB); PG8_STAGE(PG8_SA(0, 1), cA + hstep, voffA);
        if (wr == 1) PG8_BAR;
        PG8_WAIT_V(4); PG8_BAR;
        PG8_STAGE(PG8_SB(1, 0), cB + kstep, voffB); PG8_STAGE(PG8_SA(1, 0), cA + kstep, voffA); PG8_STAGE(PG8_SB(1, 1), cB + hstep + kstep, voffB);
        PG8_WAIT_V(6); PG8_BAR;
    }
    for (;;) {
        const bool has_next = S.next(ui + 1, nxt);
        const char* nA = has_next ? (const char*)g.A + (size_t)nxt.pm * tstep : cA; const char* nB = has_next ? (const char*)g.Bt + (size_t)nxt.pn * tstep : cB;
        for (int t = 0; t < nt; t += 2) {
            const bool last = (t == nt - 2);
            const char* a1 = cA + (size_t)(t + 1) * kstep;
            const char* a2 = last ? nA : cA + (size_t)(t + 2) * kstep; const char* b2 = last ? nB : cB + (size_t)(t + 2) * kstep;
            const char* a3 = a2 + kstep; const char* b3 = b2 + kstep;
            if (last && has_next) S.a_ready(nxt);
            if constexpr (SP2) {
            PG8_LDB(B0, 0, 0); PG8_LDB(B1, 0, 1); PG8_SCHED; PG8_LDA(At, 0, 0); PG8_STAGE(PG8_SA(1, 1), a1 + hstep, voffA);
            PG8_WAIT_V(8); PG8_WAIT_L(0); PG8_BAR; PG8_MMA(0, 0, At, B0); PG8_MMA(0, 1, At, B1); PG8_BAR; PG8_SCHED;
            PG8_LDA(At, 0, 1); PG8_STAGE(PG8_SB(0, 0), b2, voffB); PG8_STAGE(PG8_SB(0, 1), b2 + hstep, voffB); PG8_STAGE(PG8_SA(0, 0), a2, voffA);
            PG8_WAIT_V(8); PG8_WAIT_L(0); PG8_BAR; PG8_MMA(1, 0, At, B0); PG8_MMA(1, 1, At, B1); PG8_BAR; PG8_SCHED;
            PG8_LDB(B0, 1, 0); PG8_LDB(B1, 1, 1); PG8_SCHED; PG8_LDA(At, 1, 0); PG8_STAGE(PG8_SA(0, 1), a2 + hstep, voffA);
            PG8_WAIT_V(8); PG8_WAIT_L(0); PG8_BAR; PG8_MMA(0, 0, At, B0); PG8_MMA(0, 1, At, B1); PG8_BAR; PG8_SCHED;
            PG8_LDA(At, 1, 1); PG8_STAGE(PG8_SB(1, 0), b3, voffB); PG8_STAGE(PG8_SB(1, 1), b3 + hstep, voffB); PG8_STAGE(PG8_SA(1, 0), a3, voffA);
            PG8_WAIT_V(8); PG8_WAIT_L(0); PG8_BAR; PG8_MMA(1, 0, At, B0); PG8_MMA(1, 1, At, B1); PG8_BAR; PG8_SCHED;
            } else {
            PG8_LDB(B0, 0, 0); PG8_SCHED; PG8_LDA(At, 0, 0); PG8_STAGE(PG8_SA(1, 1), a1 + hstep, voffA);
            PG8_WAIT_L(8); PG8_BAR; PG8_WAIT_L(0); PG8_MMA(0, 0, At, B0); PG8_BAR; PG8_SCHED;
            PG8_LDB(B1, 0, 1); PG8_STAGE(PG8_SB(0, 0), b2, voffB);
            PG8_BAR; PG8_WAIT_L(0); PG8_MMA(0, 1, At, B1); PG8_BAR;
            PG8_LDA(At, 0, 1); PG8_STAGE(PG8_SA(0, 0), a2, voffA);
            PG8_BAR; PG8_WAIT_L(0); PG8_MMA(1, 0, At, B0); PG8_BAR; PG8_SCHED;
            PG8_STAGE(PG8_SB(0, 1), b2 + hstep, voffB);
            PG8_WAIT_V(6); PG8_BAR; PG8_MMA(1, 1, At, B1); PG8_BAR;
            PG8_LDB(B0, 1, 0); PG8_SCHED; PG8_LDA(At, 1, 0); PG8_STAGE(PG8_SA(0, 1), a2 + hstep, voffA);
            PG8_WAIT_L(8); PG8_BAR; PG8_WAIT_L(0); PG8_MMA(0, 0, At, B0); PG8_BAR; PG8_SCHED;
            PG8_LDB(B1, 1, 1); PG8_STAGE(PG8_SB(1, 0), b3, voffB);
            PG8_BAR; PG8_WAIT_L(0); PG8_MMA(0, 1, At, B1); PG8_BAR;
            PG8_LDA(At, 1, 1); PG8_STAGE(PG8_SA(1, 0), a3, voffA);
            PG8_BAR; PG8_WAIT_L(0); PG8_MMA(1, 0, At, B0); PG8_BAR; PG8_SCHED;
            PG8_STAGE(PG8_SB(1, 1), b3 + hstep, voffB);
            PG8_WAIT_V(6); PG8_BAR; PG8_MMA(1, 1, At, B1); PG8_BAR;
            }
        }
        if constexpr (ALIGN_EPI) { if (wr == 0) PG8_BAR; }
        if constexpr (!Epi::AFTER_DRAIN) { E(acc, cur, wr, wc, fr, fq); S.done(cur); }
        if (!has_next) break;
#pragma unroll
        for (int a = 0; a < 2; ++a)
#pragma unroll
            for (int b = 0; b < 2; ++b)
#pragma unroll
                for (int m = 0; m < 4; ++m)
#pragma unroll
                    for (int n = 0; n < 2; ++n) acc[a][b][m][n] = (f32x4){0.f, 0.f, 0.f, 0.f};
        cur = nxt; cA = nA; cB = nB; ++ui;
        if constexpr (ALIGN_EPI) { if (wr == 1) PG8_BAR; }
    }
    PG8_WAIT_V(0);
    if constexpr (!ALIGN_EPI) { if (wr == 0) PG8_BAR; }
    PG8_BAR;
    if constexpr (Epi::AFTER_DRAIN) { E.fused(acc, cur, wr, wc, fr, fq, lds, wid, lane); S.done(cur); }
#undef PG8_SA
#undef PG8_SB
#undef PG8_STAGE
#undef PG8_LDA
#undef PG8_LDB
#undef PG8_MMA
#undef PG8_WAIT_V
#undef PG8_WAIT_L
#undef PG8_BAR
#undef PG8_SCHED
}
}

using pg8::bf16_t; using pg8::f32x4; using pg8::u32x4; using pg8::bf16x8; using pg8::Unit; using pg8::cvt_pk_bf16;
#define LAS __attribute__((address_space(3)))
constexpr int DM = 1024, NB = 8, SEQ = 4096, NMETA = 16, M0 = NB * SEQ  , MP = M0 + 256  , MVALID = M0 + NMETA;
constexpr int DFF = 2816, NLAYER = 2;
constexpr float EPS = 1e-6f, LOG2E = 1.4426950408889634f;
constexpr float MLA_QSCALE = 0.10206207261596575f * LOG2E;
constexpr float DIFF_QSCALE = 0.125f * LOG2E;
constexpr int NPOS = 4352;
enum { I_X = 0, I_META, I_NMIXPRE, I_NMIXPOST, I_NFFNPRE, I_NFFNPOST, I_WIN, I_QNORM, I_KVNORM, I_WUQ, I_WUKV, I_WOMLA, I_LAMBDA, I_SUBLN, I_WODIFF, I_WOUT, I_WGU, I_WDOWN };
constexpr size_t QMiB = 1u << 18;
constexpr size_t WS_BAR = 14 * QMiB  , WS_BAR_BYTES = 16384;
constexpr size_t WS_LAM = 0, WS_ROPE = 4096, WS_SSQQ = 4 * QMiB  , WS_SSQKV = 9 * QMiB  , WS_RM = 12 * QMiB, WS_W = 16 * QMiB, WS_WSTRIDE = 124 * QMiB;
constexpr size_t WO_INA = 0, WO_INB = 18 * QMiB, WO_UQ = 34 * QMiB, WO_UKV = 37 * QMiB, WO_OMLA = 40 * QMiB, WO_ODIFF = 44 * QMiB, WO_OUT = 48 * QMiB, WO_GU = 56 * QMiB, WO_DOWN = 100 * QMiB;
constexpr size_t WS_XN = 264 * QMiB;
constexpr size_t WS_QD = 524 * QMiB, WS_KD = 654 * QMiB, WS_VD = 784 * QMiB, WS_QA = 914 * QMiB, WS_KA = 1109 * QMiB, WS_VA = 1304 * QMiB, WS_QL = 1434 * QMiB, WS_KVL = 1532 * QMiB;
constexpr size_t WS_AOA = 1600 * QMiB, WS_AOB = 1730 * QMiB, WS_G = 524 * QMiB, WS_MIXIN = 1044 * QMiB, WS_MIX = 1304 * QMiB, WS_FF = 524 * QMiB, WS_FFO = 1600 * QMiB  ;
constexpr size_t WS_O1 = 1860 * QMiB;
constexpr size_t WS_END = 1988 * QMiB;
static_assert(WS_QD + (size_t)MP * 512 * 2 <= WS_KD && WS_KD + (size_t)MP * 512 * 2 <= WS_VD && WS_VD + (size_t)MP * 512 * 2 <= WS_QA && WS_QA + (size_t)MP * 768 * 2 <= WS_KA && WS_KA + (size_t)MP * 768 * 2 <= WS_VA, "map1");
static_assert(WS_VA + (size_t)MP * 512 * 2 <= WS_QL && WS_QL + (size_t)MP * 384 * 2 <= WS_KVL && WS_KVL + (size_t)MP * 256 * 2 <= WS_AOA && WS_AOA + (size_t)MP * 512 * 2 <= WS_AOB && WS_AOB + (size_t)MP * 512 * 2 <= WS_O1, "map2");
static_assert(WS_G + (size_t)MP * 2048 * 2 <= WS_MIXIN && WS_MIXIN + (size_t)MP * 1024 * 2 <= WS_MIX && WS_MIX + (size_t)MP * 1024 * 2 <= WS_AOA && WS_FF + (size_t)MP * DFF * 2 <= WS_MIX && WS_FFO + (size_t)MP * 1024 * 2 <= WS_O1 && WS_XN + (size_t)MP * 1024 * 2 <= WS_QD, "map3");
static_assert(WO_INA + 2304 * 1024 * 2 <= WO_INB && WO_INB + 2048 * 1024 * 2 <= WO_UQ && WO_UQ + 768 * 384 * 2 <= WO_UKV && WO_UKV + 1024 * 256 * 2 <= WO_OMLA && WO_GU + 5632 * 1024 * 2 <= WO_DOWN && WO_DOWN + 1024 * 2816 * 2 <= WS_WSTRIDE, "wmap");
static_assert(WS_W + 2 * WS_WSTRIDE <= WS_XN && WS_ROPE + (size_t)NPOS * 24 * 8 <= WS_SSQQ && WS_SSQQ + (size_t)MP * 8 * 4 <= WS_SSQKV && WS_SSQKV + (size_t)MP * 4 * 4 <= WS_RM, "map4");

struct Params { const float* in[18]; float* out; unsigned char* ws; double invrev[24]; };

__device__ __forceinline__ unsigned f2bf(float f) { unsigned u = __builtin_bit_cast(unsigned, f); return (u + 0x7fffu + ((u >> 16) & 1u)) >> 16; }
__device__ __forceinline__ unsigned pk2(float lo, float hi) { return f2bf(lo) | (f2bf(hi) << 16); }
__device__ __forceinline__ float bflo(unsigned w) { return __builtin_bit_cast(float, w << 16); }
__device__ __forceinline__ float bfhi(unsigned w) { return __builtin_bit_cast(float, w & 0xffff0000u); }
__device__ __forceinline__ void st8(bf16_t* p, f32x4 v0, f32x4 v1) {
    u32x4 w; w.x = cvt_pk_bf16(v0[0], v0[1]); w.y = cvt_pk_bf16(v0[2], v0[3]); w.z = cvt_pk_bf16(v1[0], v1[1]); w.w = cvt_pk_bf16(v1[2], v1[3]); *(u32x4*)p = w; }
__device__ __forceinline__ void ld8(const bf16_t* p, f32x4& v0, f32x4& v1) {
    const u32x4 w = *(const u32x4*)p; v0 = (f32x4){bflo(w.x), bfhi(w.x), bflo(w.y), bfhi(w.y)}; v1 = (f32x4){bflo(w.z), bfhi(w.z), bflo(w.w), bfhi(w.w)}; }
__device__ __forceinline__ float sigmoidf_(float x) { return __builtin_amdgcn_rcpf(1.0f + __builtin_amdgcn_exp2f(-x * LOG2E)); }
__device__ __forceinline__ int row_pos(int row) { return row < M0 ? NMETA + (row & (SEQ - 1)) : row - M0; }
__device__ __forceinline__ void rope4(f32x4& v0, f32x4& v1, const float* t) {
    const f32x4 c0 = *(const f32x4*)t, c1 = *(const f32x4*)(t + 4);
    float a, b;
    a = v0[0]; b = v0[1]; v0[0] = a * c0[0] - b * c0[1]; v0[1] = b * c0[0] + a * c0[1];
    a = v0[2]; b = v0[3]; v0[2] = a * c0[2] - b * c0[3]; v0[3] = b * c0[2] + a * c0[3];
    a = v1[0]; b = v1[1]; v1[0] = a * c1[0] - b * c1[1]; v1[1] = b * c1[0] + a * c1[1];
    a = v1[2]; b = v1[3]; v1[2] = a * c1[2] - b * c1[3]; v1[3] = b * c1[2] + a * c1[3];
}
__device__ __forceinline__ float sumsq4(f32x4 v) { return (v[0] * v[0] + v[1] * v[1]) + (v[2] * v[2] + v[3] * v[3]); }
__device__ __forceinline__ float wave_sum(float v, int lane) {
#pragma unroll
    for (int o = 1; o < 64; o <<= 1) v += shx(v, o, lane);
    return v;
}

typedef const f32x4 (&AccRef)[2][2][4][2];
struct EpiPlain {
    static constexpr bool PERM = true, AFTER_DRAIN = false;
    bf16_t* O; int ldc;
    __device__ __forceinline__ void operator()(AccRef acc, const Unit& u, int wr, int wc, int fr_, int fq_) const { run<false>(acc, u, wr, wc, fr_, fq_); }
    template <bool MINI> __device__ __forceinline__ void run(AccRef acc, const Unit& u, int wr, int wc, int fr_, int fq_) const {
        const int ln_ = fresh_tid(0), fr = ln_ & 15, fq = ln_ >> 4; (void)fr_; (void)fq_;
        const int row0 = u.pm * 256 + wr * 64 + fr, colw = u.pn * 256 + wc * 32 + 8 * fq;
#pragma unroll
        for (int ai = 0; ai < (MINI ? 1 : 2); ++ai)
#pragma unroll
            for (int m = 0; m < (MINI ? 1 : 4); ++m) { const int row = row0 + ai * 128 + m * 16;
#pragma unroll
                for (int bj = 0; bj < 2; ++bj) st8(O + (size_t)row * ldc + colw + bj * 128, acc[ai][bj][m][0], acc[ai][bj][m][1]); }
    }
};
struct EpiInA {
    static constexpr bool PERM = true, AFTER_DRAIN = false;
    bf16_t *QD, *KD, *VD, *KVL, *QL, *KA; float *ssq_q, *ssq_kv; const float* rope;
    template <bool MINI> static __device__ __forceinline__ void lat(AccRef acc, bf16_t* dst, int ld, float* sq, int nslot, int slot, int row0, int cw, int fr, int fq) {
#pragma unroll
        for (int ai = 0; ai < (MINI ? 1 : 2); ++ai)
#pragma unroll
            for (int m = 0; m < (MINI ? 1 : 4); ++m) { const int row = row0 + ai * 128 + m * 16; float s = 0.f;
#pragma unroll
                for (int bj = 0; bj < 2; ++bj) { const f32x4 v0 = acc[ai][bj][m][0], v1 = acc[ai][bj][m][1]; s += sumsq4(v0) + sumsq4(v1); st8(dst + (size_t)row * ld + bj * 128 + cw, v0, v1); }
                s += shx(s, 16, fr + 16 * fq); s += shx(s, 32, fr + 16 * fq);
                if (fq == 0) sq[(size_t)row * nslot + slot] = s; }
    }
    __device__ __forceinline__ void operator()(AccRef acc, const Unit& u, int wr, int wc, int fr_, int fq_) const { run<false>(acc, u, wr, wc, fr_, fq_); }
    template <bool MINI> __device__ __forceinline__ void run(AccRef acc, const Unit& u, int wr, int wc, int fr_, int fq_) const {
        const int ln_ = fresh_tid(0), fr = ln_ & 15, fq = ln_ >> 4; (void)fr_; (void)fq_;
        const int pn = u.pn, row0 = u.pm * 256 + wr * 64 + fr, cw = wc * 32 + 8 * fq;
        if (pn < 6) {
            static_assert(WS_KD - WS_QD == WS_VD - WS_KD, "QD/KD/VD equally spaced");
            bf16_t* dst = QD + (size_t)(pn >> 1) * ((WS_KD - WS_QD) / 2);
            const int cbase = (pn & 1) * 256;
            const bool dorope = (pn < 4) && ((wc & 1) == 0) && (fq < 2);
            const float sc = pn < 2 ? DIFF_QSCALE : 1.0f;
#pragma unroll
            for (int ai = 0; ai < (MINI ? 1 : 2); ++ai)
#pragma unroll
                for (int m = 0; m < (MINI ? 1 : 4); ++m) { const int row = row0 + ai * 128 + m * 16; const float* rt = rope + (size_t)row_pos(row) * 48 + 2 * (16 + 4 * fq);
#pragma unroll
                    for (int bj = 0; bj < 2; ++bj) { f32x4 v0 = acc[ai][bj][m][0], v1 = acc[ai][bj][m][1];
                        if (dorope) rope4(v0, v1, rt);
                        v0 = v0 * sc; v1 = v1 * sc; st8(dst + (size_t)row * 512 + cbase + bj * 128 + cw, v0, v1); } }
        } else if (pn == 6) { lat<MINI>(acc, KVL, 256, ssq_kv, 4, wc, row0, cw, fr, fq);
        } else if (pn == 7) { lat<MINI>(acc, QL, 384, ssq_q, 8, wc, row0, cw, fr, fq);
        } else {
#pragma unroll
            for (int ai = 0; ai < (MINI ? 1 : 2); ++ai)
#pragma unroll
                for (int m = 0; m < (MINI ? 1 : 4); ++m) { const int row = row0 + ai * 128 + m * 16;
                    { const f32x4 v0 = acc[ai][0][m][0], v1 = acc[ai][0][m][1]; float s = sumsq4(v0) + sumsq4(v1); st8(QL + (size_t)row * 384 + 256 + cw, v0, v1);
                      s += shx(s, 16, fr + 16 * fq); s += shx(s, 32, fr + 16 * fq);
                      if (fq == 0) ssq_q[(size_t)row * 8 + 4 + wc] = s; }
                    if (wc == 0) { f32x4 v0 = acc[ai][1][m][0], v1 = acc[ai][1][m][1]; rope4(v0, v1, rope + (size_t)row_pos(row) * 48 + 2 * (4 * fq));
                        u32x4 w; w.x = cvt_pk_bf16(v0[0], v0[1]); w.y = cvt_pk_bf16(v0[2], v0[3]); w.z = cvt_pk_bf16(v1[0], v1[1]); w.w = cvt_pk_bf16(v1[2], v1[3]);
#pragma unroll
                        for (int h = 0; h < 8; ++h) *(u32x4*)(KA + (size_t)row * 768 + h * 96 + 64 + 8 * fq) = w; } }
        }
    }
};
struct EpiQA {
    static constexpr bool PERM = true, AFTER_DRAIN = false;
    bf16_t* QA; const float* ssq_q; const float* rope;
    __device__ __forceinline__ void operator()(AccRef acc, const Unit& u, int wr, int wc, int fr_, int fq_) const { run<false>(acc, u, wr, wc, fr_, fq_); }
    template <bool MINI> __device__ __forceinline__ void run(AccRef acc, const Unit& u, int wr, int wc, int fr_, int fq_) const {
        const int ln_ = fresh_tid(0), fr = ln_ & 15, fq = ln_ >> 4; (void)fr_; (void)fq_;
        const int row0 = u.pm * 256 + wr * 64 + fr, colw = u.pn * 256 + wc * 32 + 8 * fq;
#pragma unroll
        for (int ai = 0; ai < (MINI ? 1 : 2); ++ai)
#pragma unroll
            for (int m = 0; m < (MINI ? 1 : 4); ++m) { const int row = row0 + ai * 128 + m * 16; const f32x4 sa = *(const f32x4*)(ssq_q + (size_t)row * 8), sb = *(const f32x4*)(ssq_q + (size_t)row * 8 + 4); const float rs = rsqrtf((((sa[0] + sa[1]) + (sa[2] + sa[3])) + ((sb[0] + sb[1]) + (sb[2] + sb[3]))) * (1.0f / 384.0f) + EPS) * MLA_QSCALE; const float* rt = rope + (size_t)row_pos(row) * 48;
#pragma unroll
                for (int bj = 0; bj < 2; ++bj) { const int col = colw + bj * 128, j = col % 96; f32x4 v0 = acc[ai][bj][m][0] * rs, v1 = acc[ai][bj][m][1] * rs;
                    if (j >= 64) rope4(v0, v1, rt + (j - 64));
                    st8(QA + (size_t)row * 768 + col, v0, v1); } }
    }
};
struct EpiKV {
    static constexpr bool PERM = true, AFTER_DRAIN = false;
    bf16_t *KA, *VA; const float* ssq_kv;
    __device__ __forceinline__ void operator()(AccRef acc, const Unit& u, int wr, int wc, int fr_, int fq_) const { run<false>(acc, u, wr, wc, fr_, fq_); }
    template <bool MINI> __device__ __forceinline__ void run(AccRef acc, const Unit& u, int wr, int wc, int fr_, int fq_) const {
        const int ln_ = fresh_tid(0), fr = ln_ & 15, fq = ln_ >> 4; (void)fr_; (void)fq_;
        const int row0 = u.pm * 256 + wr * 64 + fr, colw = u.pn * 256 + wc * 32 + 8 * fq;
#pragma unroll
        for (int ai = 0; ai < (MINI ? 1 : 2); ++ai)
#pragma unroll
            for (int m = 0; m < (MINI ? 1 : 4); ++m) { const int row = row0 + ai * 128 + m * 16; const f32x4 sa = *(const f32x4*)(ssq_kv + (size_t)row * 4); const float rs = rsqrtf(((sa[0] + sa[1]) + (sa[2] + sa[3])) * (1.0f / 256.0f) + EPS);
#pragma unroll
                for (int bj = 0; bj < 2; ++bj) { const int c = colw + bj * 128; const f32x4 v0 = acc[ai][bj][m][0] * rs, v1 = acc[ai][bj][m][1] * rs;
                    bf16_t* dst = (u.pn < 2) ? KA + (size_t)row * 768 + (c >> 6) * 96 + (c & 63) : VA + (size_t)row * 512 + (c - 512);
                    st8(dst, v0, v1); } }
    }
};
struct EpiGate {
    static constexpr bool PERM = true, AFTER_DRAIN = false;
    bf16_t* G; int goff;
    __device__ __forceinline__ void operator()(AccRef acc, const Unit& u, int wr, int wc, int fr_, int fq_) const { run<false>(acc, u, wr, wc, fr_, fq_); }
    template <bool MINI> __device__ __forceinline__ void run(AccRef acc, const Unit& u, int wr, int wc, int fr_, int fq_) const {
        const int ln_ = fresh_tid(0), fr = ln_ & 15, fq = ln_ >> 4; (void)fr_; (void)fq_;
        const int row0 = u.pm * 256 + wr * 64 + fr, colw = u.pn * 256 + wc * 32 + 8 * fq;
#pragma unroll
        for (int ai = 0; ai < (MINI ? 1 : 2); ++ai)
#pragma unroll
            for (int m = 0; m < (MINI ? 1 : 4); ++m) { const int row = row0 + ai * 128 + m * 16;
#pragma unroll
                for (int bj = 0; bj < 2; ++bj) { f32x4 v0 = acc[ai][bj][m][0], v1 = acc[ai][bj][m][1];
#pragma unroll
                    for (int e = 0; e < 4; ++e) { v0[e] = sigmoidf_(v0[e]); v1[e] = sigmoidf_(v1[e]); }
                    st8(G + (size_t)row * 2048 + goff + colw + bj * 128, v0, v1); } }
    }
};
template <bool ADD> struct EpiMix {
    static constexpr bool PERM = true, AFTER_DRAIN = false;
    bf16_t* MIXIN; const bf16_t* G; int goff;
    __device__ __forceinline__ void operator()(AccRef acc, const Unit& u, int wr, int wc, int fr_, int fq_) const { run<false>(acc, u, wr, wc, fr_, fq_); }
    template <bool MINI> __device__ __forceinline__ void run(AccRef acc, const Unit& u, int wr, int wc, int fr_, int fq_) const {
        const int ln_ = fresh_tid(0), fr = ln_ & 15, fq = ln_ >> 4; (void)fr_; (void)fq_;
        const int row0 = u.pm * 256 + wr * 64 + fr, colw = u.pn * 256 + wc * 32 + 8 * fq;
#pragma unroll
        for (int ai = 0; ai < (MINI ? 1 : 2); ++ai)
#pragma unroll
            for (int m = 0; m < (MINI ? 1 : 4); ++m) { const int row = row0 + ai * 128 + m * 16;
#pragma unroll
                for (int bj = 0; bj < 2; ++bj) { const int col = colw + bj * 128; f32x4 g0, g1; ld8(G + (size_t)row * 2048 + goff + col, g0, g1);
                    f32x4 v0 = acc[ai][bj][m][0] * g0, v1 = acc[ai][bj][m][1] * g1;
                    if (ADD) { f32x4 p0, p1; ld8(MIXIN + (size_t)row * 1024 + col, p0, p1); v0 = v0 + p0; v1 = v1 + p1; }
                    st8(MIXIN + (size_t)row * 1024 + col, v0, v1); } }
    }
};
struct EpiSwiglu {
    static constexpr bool PERM = true, AFTER_DRAIN = false;
    bf16_t* FF;
    __device__ __forceinline__ void operator()(AccRef acc, const Unit& u, int wr, int wc, int fr_, int fq_) const { run<false>(acc, u, wr, wc, fr_, fq_); }
    template <bool MINI> __device__ __forceinline__ void run(AccRef acc, const Unit& u, int wr, int wc, int fr_, int fq_) const {
        const int ln_ = fresh_tid(0), fr = ln_ & 15, fq = ln_ >> 4; (void)fr_; (void)fq_;
        const int row0 = u.pm * 256 + wr * 64 + fr, col = u.pn * 128 + wc * 32 + 8 * fq;
#pragma unroll
        for (int ai = 0; ai < (MINI ? 1 : 2); ++ai)
#pragma unroll
            for (int m = 0; m < (MINI ? 1 : 4); ++m) { const int row = row0 + ai * 128 + m * 16;
                f32x4 g0 = acc[ai][0][m][0], g1 = acc[ai][0][m][1]; const f32x4 u0 = acc[ai][1][m][0], u1 = acc[ai][1][m][1];
#pragma unroll
                for (int e = 0; e < 4; ++e) { g0[e] = g0[e] * sigmoidf_(g0[e]) * u0[e]; g1[e] = g1[e] * sigmoidf_(g1[e]) * u1[e]; }
                st8(FF + (size_t)row * DFF + col, g0, g1); }
    }
};

template <class Epi> __device__ __forceinline__ void mini_gemm(LAS unsigned char* lds, int wave_, const bf16_t* __restrict__ A, const bf16_t* __restrict__ Bt, int N, int K, const Epi& E) {
    const int nunits = (N / 256) * 4, mu = launder_s((int)gridDim.x - 1 - (int)blockIdx.x);
    if (mu >= nunits) return;
    const int pn = mu >> 2, wc = mu & 3, lane = fresh_tid(0), fr = lane & 15, fq = lane >> 4;
    const int wave = launder_s(wave_); const bool w0 = wave == 0;
    f32x4 acc[2][2][4][2];
#pragma unroll
    for (int bj = 0; bj < 2; ++bj)
#pragma unroll
        for (int n = 0; n < 2; ++n) acc[0][bj][0][n] = (f32x4){0.f, 0.f, 0.f, 0.f};
    const bf16_t* ap = A + (size_t)(M0 + fr) * K + 8 * fq;
    const bf16_t* bp = Bt + (size_t)(256 * pn + 32 * wc + 8 * (fr >> 2) + (fr & 3)) * K + 8 * fq;
    for (int kb0 = 32 * wave; kb0 < K; kb0 += 1024) {
        bf16x8 a[4], b[4][4];
#pragma unroll
        for (int t = 0; t < 4; ++t) { const int k0 = kb0 + 256 * t;
            if (k0 < K) { a[t] = *(const bf16x8*)(ap + k0);
#pragma unroll
                for (int q = 0; q < 4; ++q) b[t][q] = *(const bf16x8*)(bp + (size_t)(128 * (q >> 1) + 4 * (q & 1)) * K + k0); } }
#pragma unroll
        for (int t = 0; t < 4; ++t) { const int k0 = kb0 + 256 * t;
            if (k0 < K) {
#pragma unroll
                for (int q = 0; q < 4; ++q) acc[0][q >> 1][0][q & 1] = __builtin_amdgcn_mfma_f32_16x16x32_bf16(b[t][q], a[t], acc[0][q >> 1][0][q & 1], 0, 0, 0); } }
    }
    LAS f32x4* part = (LAS f32x4*)lds;
#pragma unroll
    for (int bj = 0; bj < 2; ++bj)
#pragma unroll
        for (int n = 0; n < 2; ++n) part[(wave * 4 + bj * 2 + n) * 64 + lane] = acc[0][bj][0][n];
    __syncthreads();
    if (w0) {
#pragma unroll
        for (int bj = 0; bj < 2; ++bj)
#pragma unroll
            for (int n = 0; n < 2; ++n) { f32x4 t = part[(bj * 2 + n) * 64 + lane];
#pragma unroll
                for (int w = 1; w < 8; ++w) t = t + part[(w * 4 + bj * 2 + n) * 64 + lane];
                acc[0][bj][0][n] = t; }
    }
    __syncthreads();
    if (w0) { const Unit u{M0 / 256, pn}; E.template run<true>(acc, u, 0, wc, fr, fq); }
}

struct PairOrder {
    pg8::StaticOrder S; int pm_off;
    __device__ bool next(int i, Unit& u) const { if (!S.next(i >> 1, u)) return false; if (i & 1) { u.pm += pm_off; u.pn += 4; } return true; }
    __device__ __forceinline__ void a_ready(const Unit&) const {}
    __device__ __forceinline__ void done(const Unit&) const {}
};
constexpr int AO_PM_OFF = (int)((WS_AOB - WS_AOA) / (256 * 512 * 2));
static_assert((WS_AOB - WS_AOA) % (256 * 512 * 2) == 0 && AO_PM_OFF >= 129 && WO_ODIFF - WO_OMLA == 1024 * 512 * 2, "the paired branch projections address AOB / W_o_diff as row tiles behind AOA / W_o_mla");
struct EpiMixPair {
    static constexpr bool PERM = true, AFTER_DRAIN = false;
    bf16_t* MIXIN; const bf16_t* G;
    __device__ __forceinline__ void operator()(AccRef acc, const Unit& u, int wr, int wc, int fr_, int fq_) const {
        const int ln_ = fresh_tid(0), fr = ln_ & 15, fq = ln_ >> 4; (void)fr_; (void)fq_;
        const bool second = u.pn >= 4; const int pm = second ? u.pm - AO_PM_OFF : u.pm, pn = second ? u.pn - 4 : u.pn, goff = second ? 1024 : 0;
        const int row0 = pm * 256 + wr * 64 + fr, colw = pn * 256 + wc * 32 + 8 * fq;
#pragma unroll
        for (int ai = 0; ai < 2; ++ai)
#pragma unroll
            for (int m = 0; m < 4; ++m) { const int row = row0 + ai * 128 + m * 16;
#pragma unroll
                for (int bj = 0; bj < 2; ++bj) { const int col = colw + bj * 128; f32x4 g0, g1; ld8(G + (size_t)row * 2048 + goff + col, g0, g1);
                    f32x4 v0 = acc[ai][bj][m][0] * g0, v1 = acc[ai][bj][m][1] * g1;
                    if (second) { f32x4 p0, p1; ld8(MIXIN + (size_t)row * 1024 + col, p0, p1); v0 = v0 + p0; v1 = v1 + p1; }
                    st8(MIXIN + (size_t)row * 1024 + col, v0, v1); } }
    }
};
template <class Epi> __device__ __forceinline__ void run_gemm_pair(LAS unsigned char* lds, int wave, const bf16_t* A, const bf16_t* Bt, int K, const Epi& E, int pm_off) {
    pg8::Gemm g{A, Bt, M0, 1024, K}; PairOrder S; S.S.init(M0, 1024, launder_s((int)gridDim.x), launder_s((int)blockIdx.x)); S.pm_off = pm_off;
#ifndef NO_GEMM
    pg8::gemm_phase<Epi, PairOrder, true, true>(lds, g, S, E, wave);
#endif
}
#ifndef ONLY_GEMM
#define ONLY_GEMM -1
#endif
#ifndef PROBE_GEMM_MASK
#define PROBE_GEMM_MASK 0
#endif
#ifndef PROBE_GEMM_REP
#define PROBE_GEMM_REP 1
#endif
template <int ID, class Epi> __device__ __forceinline__ void run_gemm1(LAS unsigned char* lds, int wave, int gwave, const bf16_t* A, const bf16_t* Bt, int N, int K, const Epi& E, int Mrows) {
    if (Mrows == MP) mini_gemm(lds, wave, A, Bt, N, K, E);
    pg8::Gemm g{A, Bt, M0, N, K}; pg8::StaticOrder S; S.init(M0, N, launder_s((int)gridDim.x), launder_s((int)blockIdx.x));
#ifndef NO_GEMM
    if constexpr (ONLY_GEMM < 0 || ONLY_GEMM == ID) pg8::gemm_phase<Epi, pg8::StaticOrder, true, true>(lds, g, S, E, wave);
#endif
}
template <int ID, class Epi> __device__ __forceinline__ void run_gemm(LAS unsigned char* lds, int wave, int gwave, const bf16_t* A, const bf16_t* Bt, int N, int K, const Epi& E, int Mrows = MP) {
    for (int r = 0; r < ((PROBE_GEMM_MASK >> ID) & 1 ? PROBE_GEMM_REP : 1); ++r) run_gemm1<ID>(lds, wave, gwave, A, Bt, N, K, E, Mrows);
}

namespace att {
__device__ __forceinline__ float pair_sum_(float v, int lane) { return v + shx(v, 32, lane); }
typedef float f32x16 __attribute__((ext_vector_type(16)));
typedef short s16x4 __attribute__((ext_vector_type(4)));
typedef short v4i16_t __attribute__((ext_vector_type(4)));
typedef LAS const char* lds_cptr;
typedef LAS char* lds_ptr;
#define MFMA32(a, b, c) __builtin_amdgcn_mfma_f32_32x32x16_bf16((a), (b), (c), 0, 0, 0)
__device__ __forceinline__ int crow(int r, int hi) { return (r & 3) + 8 * (r >> 2) + 4 * hi; }
__device__ __forceinline__ s16x4 vtr(lds_cptr p) { return __builtin_bit_cast(s16x4, __builtin_amdgcn_ds_read_tr16_b64_v4i16((LAS v4i16_t*)p)); }
__device__ __forceinline__ bf16x8 pack8(const f32x16& p, int s) {
    u32x4 w; w.x = cvt_pk_bf16(p[8 * s], p[8 * s + 1]); w.y = cvt_pk_bf16(p[8 * s + 2], p[8 * s + 3]); w.z = cvt_pk_bf16(p[8 * s + 4], p[8 * s + 5]); w.w = cvt_pk_bf16(p[8 * s + 6], p[8 * s + 7]);
    return __builtin_bit_cast(bf16x8, w); }

template <int DK, int DV> struct Geo {
    static constexpr int NPK = DK / 8, NPV = DV / 8, KPS = 1024, VPS = 1088, KBYTES = NPK * KPS, VBYTES = NPV * VPS, NSLOT = 3;
};
template <int DK, int DV>
__device__ __forceinline__ void qk_tile(lds_cptr Kb, const bf16x8 (&qf)[DK / 16], int r32, int hi, f32x16& p0, f32x16& p1) {
    typedef Geo<DK, DV> G;
    f32x16 z;
#pragma unroll
    for (int i = 0; i < 16; ++i) z[i] = 0.f;
#pragma unroll
    for (int ds = 0; ds < DK / 16; ++ds) {
        const bf16x8 a0 = *(const LAS bf16x8*)(Kb + (2 * ds + hi) * G::KPS + r32 * 16);
        const bf16x8 a1 = *(const LAS bf16x8*)(Kb + (2 * ds + hi) * G::KPS + (32 + r32) * 16);
        if (ds == 0) { p0 = MFMA32(a0, qf[0], z); p1 = MFMA32(a1, qf[0], z); } else { p0 = MFMA32(a0, qf[ds], p0); p1 = MFMA32(a1, qf[ds], p1); }
    }
}
template <int DV, bool NEGM>
__device__ __forceinline__ void max_rescale(f32x16& p0, f32x16& p1, float& m, float& l, f32x16 (&o)[DV / 32], f32x16& negm, int lane, bool first) {
    float ra = fmaxf(fmaxf(p0[0], p0[1]), p1[0]), rb = fmaxf(fmaxf(p0[2], p0[3]), p1[1]); ra = fmaxf(fmaxf(ra, p1[2]), p1[3]);
#pragma unroll
    for (int i = 4; i < 16; i += 4) { ra = fmaxf(fmaxf(ra, p0[i]), p0[i + 1]); rb = fmaxf(fmaxf(rb, p0[i + 2]), p0[i + 3]); ra = fmaxf(fmaxf(ra, p1[i]), p1[i + 1]); rb = fmaxf(fmaxf(rb, p1[i + 2]), p1[i + 3]); }
    float rm = fmaxf(ra, rb);
    rm = fmaxf(rm, shx(rm, 32, lane));
    if (NEGM) {
        if (first || __builtin_amdgcn_ballot_w64(rm > 8.0f) != 0ull) {
            const float dl = first ? rm : fmaxf(rm, 0.f), alpha = first ? 1.0f : __builtin_amdgcn_exp2f(-dl); m += dl; l *= alpha;
#pragma unroll
            for (int i = 0; i < 16; ++i) { p0[i] -= dl; p1[i] -= dl; negm[i] = -m; }
#pragma unroll
            for (int d0 = 0; d0 < DV / 32; ++d0)
#pragma unroll
                for (int i = 0; i < 16; ++i) o[d0][i] *= alpha;
        }
    } else {
        if (__builtin_amdgcn_ballot_w64(rm > m + 8.0f) != 0ull) {
            const float mn = fmaxf(m, rm), alpha = __builtin_amdgcn_exp2f(m - mn); m = mn; l *= alpha;
#pragma unroll
            for (int d0 = 0; d0 < DV / 32; ++d0)
#pragma unroll
                for (int i = 0; i < 16; ++i) o[d0][i] *= alpha;
        }
    }
}
template <int DK, int DV, bool NEXT, bool NEGM>
__device__ __forceinline__ void fused_step(lds_cptr Kn, lds_cptr Vc, const bf16x8 (&qf)[DK / 16], bf16x8 ka0, bf16x8 ka1, const f32x16& cinit, f32x16& c0, f32x16& c1, f32x16& n0, f32x16& n1, float m, float& l, f32x16 (&o)[DV / 32],
                                           int r32, int hi, int q4, int p4, int blk) {
    typedef Geo<DK, DV> G;
    constexpr int NDS = DK / 16, ND0 = DV / 32;
    const lds_cptr kp = Kn + hi * G::KPS + r32 * 16;
    const lds_cptr vp = Vc + (2 * blk + (p4 >> 1)) * G::VPS + (4 * hi + q4) * 16 + 8 * (p4 & 1);
    bf16x8 ka[2][2]; ka[0][0] = ka0; ka[0][1] = ka1;
    s16x4 vlo[2][ND0], vhi[2][ND0];
#pragma unroll
    for (int ds = 0; ds < NDS; ++ds) {
        if (NEXT && ds + 1 < NDS) { ka[(ds + 1) & 1][0] = *(const LAS bf16x8*)(kp + (ds + 1) * 2 * G::KPS); ka[(ds + 1) & 1][1] = *(const LAS bf16x8*)(kp + (ds + 1) * 2 * G::KPS + 512); }
        if (ds == NDS - 1) {
#pragma unroll
            for (int d0 = 0; d0 < ND0; ++d0) { vlo[0][d0] = vtr(vp + d0 * 4 * G::VPS); vhi[0][d0] = vtr(vp + d0 * 4 * G::VPS + 128); }
        }
        if (NEXT) { if (ds == 0) { n0 = MFMA32(ka[0][0], qf[0], cinit); n1 = MFMA32(ka[0][1], qf[0], cinit); } else { n0 = MFMA32(ka[ds & 1][0], qf[ds], n0); n1 = MFMA32(ka[ds & 1][1], qf[ds], n1); } }
#pragma unroll
        for (int e = (ds * 32) / NDS; e < ((ds + 1) * 32) / NDS; ++e) { if (e < 16) c0[e] = __builtin_amdgcn_exp2f(NEGM ? c0[e] : c0[e] - m); else c1[e - 16] = __builtin_amdgcn_exp2f(NEGM ? c1[e - 16] : c1[e - 16] - m); }
        __builtin_amdgcn_sched_barrier(0);
    }
    float ls = 0.f;
#pragma unroll
    for (int c = 0; c < 4; ++c) {
        if (c + 1 < 4) {
#pragma unroll
            for (int d0 = 0; d0 < ND0; ++d0) { vlo[(c + 1) & 1][d0] = vtr(vp + d0 * 4 * G::VPS + (c + 1) * 256); vhi[(c + 1) & 1][d0] = vtr(vp + d0 * 4 * G::VPS + (c + 1) * 256 + 128); }
        }
        const f32x16& cc = (c >> 1) == 0 ? c0 : c1; const int s = c & 1;
        const bf16x8 pk = pack8(cc, s);
        ls += ((cc[8 * s] + cc[8 * s + 1]) + (cc[8 * s + 2] + cc[8 * s + 3])) + ((cc[8 * s + 4] + cc[8 * s + 5]) + (cc[8 * s + 6] + cc[8 * s + 7]));
#pragma unroll
        for (int d0 = 0; d0 < ND0; ++d0) {
            const bf16x8 vf = __builtin_shufflevector(vlo[c & 1][d0], vhi[c & 1][d0], 0, 1, 2, 3, 4, 5, 6, 7);
            o[d0] = MFMA32(vf, pk, o[d0]);
        }
        __builtin_amdgcn_sched_barrier(0);
    }
    l += ls;
}
template <int DK, int DV>
__device__ __forceinline__ void attn_pass(lds_ptr lds, int wave, const bf16_t* Q, int qpitch, int qrow, const bf16_t* __restrict__ K, int kpitch, const bf16_t* __restrict__ V, int vpitch,
                                          int xrow0, int ntiles, int qlim_meta, int qs, int wave_last_s, f32x16 (&o)[DV / 32], float& linv) {
    typedef Geo<DK, DV> G;
    const int tid = fresh_tid(wave), lane = tid & 63, r32 = lane & 31, hi = lane >> 5;
    bf16x8 qf[DK / 16];
#pragma unroll
    for (int ds = 0; ds < DK / 16; ++ds) qf[ds] = *(const bf16x8*)(Q + (size_t)qrow * qpitch + 16 * ds + 8 * hi);
    constexpr bool NEGM = (DK == 96);
    float m = NEGM ? 0.f : -1e30f, l = 0.f;
    f32x16 negm;
#pragma unroll
    for (int i = 0; i < 16; ++i) negm[i] = 0.f;
#pragma unroll
    for (int d0 = 0; d0 < DV / 32; ++d0)
#pragma unroll
        for (int i = 0; i < 16; ++i) o[d0][i] = 0.f;
    const lds_ptr KB0 = lds, VB0 = lds + G::NSLOT * G::KBYTES;
    const int wv = launder_s(wave);
    constexpr int NKW = (G::NPK + 7) / 8, NVW = (G::NPV + 7) / 8;
    const int nkw = (wv + 8 * (NKW - 1) < G::NPK) ? NKW : NKW - 1, nvw = (wv + 8 * (NVW - 1) < G::NPV) ? NVW : NVW - 1;
#define ATT_GROW(t) ((t) == 0 ? (size_t)M0 : (size_t)xrow0 + 64 * ((t) - 1))
#define ATT_DMAK(t, slot) do { const bf16_t* src_ = K + (ATT_GROW(t) + lane) * kpitch; \
        _Pragma("unroll") for (int i = 0; i < NKW; ++i) { const int c_ = wv + 8 * i; if (c_ < G::NPK) \
            __builtin_amdgcn_global_load_lds((const unsigned*)(src_ + c_ * 8), (LAS unsigned*)(KB0 + (slot) * G::KBYTES + c_ * G::KPS), 16, 0, 0); } } while (0)
#define ATT_DMAV(t, slot) do { const bf16_t* src_ = V + (ATT_GROW(t) + lane) * vpitch; \
        _Pragma("unroll") for (int i = 0; i < NVW; ++i) { const int c_ = wv + 8 * i; if (c_ < G::NPV) \
            __builtin_amdgcn_global_load_lds((const unsigned*)(src_ + c_ * 8), (LAS unsigned*)(VB0 + (slot) * G::VBYTES + c_ * G::VPS), 16, 0, 0); } } while (0)
#define ATT_WAIT_BAR(n) do { const int n_ = (n); \
        if (n_ == 0) asm volatile("s_waitcnt vmcnt(0) lgkmcnt(0)" ::: "memory"); else if (n_ == 1) asm volatile("s_waitcnt vmcnt(1) lgkmcnt(0)" ::: "memory"); \
        else if (n_ == 2) asm volatile("s_waitcnt vmcnt(2) lgkmcnt(0)" ::: "memory"); else if (n_ == 3) asm volatile("s_waitcnt vmcnt(3) lgkmcnt(0)" ::: "memory"); \
        else asm volatile("s_waitcnt vmcnt(4) lgkmcnt(0)" ::: "memory"); \
        __builtin_amdgcn_s_barrier(); asm volatile("" ::: "memory"); } while (0)
#define ATT_ACTIVE(j) ((j) == 0 || 64 * ((j) - 1) <= wave_last_s)
#define ATT_NEEDMASK(j) ((j) == 0 || 64 * ((j) - 1) + 63 > wave_last_s - 31)
    asm volatile("s_waitcnt vmcnt(0)" ::: "memory");
    ATT_DMAK(0, 0); ATT_DMAV(0, 0); if (ntiles > 1) ATT_DMAK(1, 1);
    int late = 0;
    if (ntiles > 1) { ATT_DMAV(1, 1); late += nvw; }
    if (ntiles > 2) { ATT_DMAK(2, 2); late += nkw; }
    ATT_WAIT_BAR(late);
    const int q4 = (lane & 15) >> 2, p4 = lane & 3, blk = (lane >> 4) & 1;
    f32x16 pA0, pA1, pB0, pB1;
    qk_tile<DK, DV>(KB0, qf, r32, hi, pA0, pA1);
    asm volatile("s_waitcnt lgkmcnt(0)" ::: "memory"); __builtin_amdgcn_s_barrier(); asm volatile("" ::: "memory");
    int sk1 = 1, sv0 = 0;
#define ATT_STEP(C0, C1, N0, N1, J) do { const int j_ = (J); int issued_ = 0; \
        if (j_ + 3 < ntiles) { ATT_DMAK(j_ + 3, sk1 == 0 ? 2 : sk1 - 1); issued_ += nkw; } \
        if (j_ + 2 < ntiles) { ATT_DMAV(j_ + 2, sv0 == 0 ? 2 : sv0 - 1); issued_ += nvw; } \
        const lds_cptr Kn_ = KB0 + sk1 * G::KBYTES; const lds_cptr Vc_ = VB0 + sv0 * G::VBYTES; \
        if (j_ < ntiles && ATT_ACTIVE(j_)) { \
              \
            const bf16x8 ka0_ = *(const LAS bf16x8*)(Kn_ + hi * G::KPS + r32 * 16), ka1_ = *(const LAS bf16x8*)(Kn_ + hi * G::KPS + (32 + r32) * 16); \
            if (ATT_NEEDMASK(j_)) { const int kvbase = (j_ == 0) ? 0 : 64 * (j_ - 1); const int qlim = (j_ == 0) ? qlim_meta : qs; \
                _Pragma("unroll") for (int i = 0; i < 16; ++i) { const int kv = kvbase + crow(i, hi); if (kv > qlim) C0[i] = -1e30f; if (kv + 32 > qlim) C1[i] = -1e30f; } } \
            max_rescale<DV, NEGM>(C0, C1, m, l, o, negm, lane, j_ == 0); \
            fused_step<DK, DV, true, NEGM>(Kn_, Vc_, qf, ka0_, ka1_, negm, C0, C1, N0, N1, m, l, o, r32, hi, q4, p4, blk); \
        } \
        sk1 = sk1 == 2 ? 0 : sk1 + 1; sv0 = sv0 == 2 ? 0 : sv0 + 1; \
        ATT_WAIT_BAR(issued_); } while (0)
    for (int j = 0; j < ntiles; j += 2) { ATT_STEP(pA0, pA1, pB0, pB1, j); ATT_STEP(pB0, pB1, pA0, pA1, j + 1); }
    asm volatile("s_waitcnt vmcnt(0)" ::: "memory");
#undef ATT_STEP
#undef ATT_GROW
#undef ATT_DMAK
#undef ATT_DMAV
#undef ATT_WAIT_BAR
#undef ATT_ACTIVE
#undef ATT_NEEDMASK
    l += shx(l, 32, lane);
    linv = 1.0f / l;
}

constexpr int LDS_NEED = 3 * ((Geo<64, 128>::KBYTES + Geo<64, 128>::VBYTES) > (Geo<96, 64>::KBYTES + Geo<96, 64>::VBYTES) ? (Geo<64, 128>::KBYTES + Geo<64, 128>::VBYTES) : (Geo<96, 64>::KBYTES + Geo<96, 64>::VBYTES));

struct Tensors { const bf16_t *QA, *KA, *VA, *QD, *KD, *VD; bf16_t *AOA, *AOB; const float* subln; float lam, lam_init; float* o1scr; };

__device__ __forceinline__ void mla_unit(lds_ptr lds, int wave, const Tensors& T, int b, int h, int qb, bool isx) {
    const int tid = fresh_tid(wave), lane = tid & 63, r32 = lane & 31, hi = lane >> 5, w = wave;
    int qrow, qs, qlim_meta, wave_last_s, ntiles, xrow0 = b * SEQ;
    if (isx) { qs = 256 * qb + 32 * w + r32; qrow = xrow0 + qs; qlim_meta = 15; wave_last_s = 256 * qb + 32 * w + 31; ntiles = 1 + 4 * (qb + 1); }
    else { qs = -1; qrow = M0 + 32 * w + r32; qlim_meta = r32 < 15 ? r32 : 15; wave_last_s = -1; ntiles = 1; if (w > 0) qlim_meta = 15; }
    f32x16 o[2]; float linv;
    attn_pass<96, 64>(lds, wave, T.QA + h * 96, 768, qrow, T.KA + h * 96, 768, T.VA + h * 64, 512, xrow0, ntiles, qlim_meta, qs, wave_last_s, o, linv);
    bf16_t* dst = T.AOA + (size_t)qrow * 512 + h * 64 + 4 * hi;
#pragma unroll
    for (int d0 = 0; d0 < 2; ++d0)
#pragma unroll
        for (int g = 0; g < 4; ++g) {
            uint2 wv; wv.x = cvt_pk_bf16(o[d0][4 * g] * linv, o[d0][4 * g + 1] * linv); wv.y = cvt_pk_bf16(o[d0][4 * g + 2] * linv, o[d0][4 * g + 3] * linv);
            *(uint2*)(dst + 32 * d0 + 8 * g) = wv; }
}
__device__ __forceinline__ void mla_unit64(lds_ptr lds, int wave, const Tensors& T, int b, int h, int qb8) {
    typedef Geo<96, 64> G; constexpr int NDS = 6, ND0 = 2;
    const int tid = fresh_tid(wave), lane = tid & 63, r32 = lane & 31, hi = lane >> 5;
    const int wv = launder_s(wave);
    const int xrow0 = b * SEQ, slab = 512 * qb8 + 64 * wv, sA = slab + r32, sB = sA + 32;
    const int ntiles = 1 + 8 * (qb8 + 1), last_active = 8 * qb8 + wv + 1;
    const bf16_t* Q = T.QA + h * 96; const bf16_t* __restrict__ K = T.KA + h * 96; const bf16_t* __restrict__ V = T.VA + h * 64;
    constexpr int kpitch = 768, vpitch = 512;
    bf16x8 qA[NDS], qB[NDS];
#pragma unroll
    for (int ds = 0; ds < NDS; ++ds) { qA[ds] = *(const bf16x8*)(Q + (size_t)(xrow0 + sA) * 768 + 16 * ds + 8 * hi); qB[ds] = *(const bf16x8*)(Q + (size_t)(xrow0 + sB) * 768 + 16 * ds + 8 * hi); }
    float mA = -1e30f, mB = -1e30f, lA = 0.f, lB = 0.f;
    f32x16 oA[ND0], oB[ND0], nz;
#pragma unroll
    for (int i = 0; i < 16; ++i) { oA[0][i] = 0.f; oA[1][i] = 0.f; oB[0][i] = 0.f; oB[1][i] = 0.f; nz[i] = 0.f; }
    const lds_ptr KB0 = lds, VB0 = lds + G::NSLOT * G::KBYTES;
    constexpr int NKW = (G::NPK + 7) / 8, NVW = (G::NPV + 7) / 8;
    const int nkw = (wv + 8 * (NKW - 1) < G::NPK) ? NKW : NKW - 1, nvw = (wv + 8 * (NVW - 1) < G::NPV) ? NVW : NVW - 1;
#define U64_GROW(t) ((t) == 0 ? (size_t)M0 : (size_t)xrow0 + 64 * ((t) - 1))
#define U64_DMAK(t, slot) do { const bf16_t* src_ = K + (U64_GROW(t) + lane) * kpitch; \
        _Pragma("unroll") for (int i = 0; i < NKW; ++i) { const int c_ = wv + 8 * i; if (c_ < G::NPK) \
            __builtin_amdgcn_global_load_lds((const unsigned*)(src_ + c_ * 8), (LAS unsigned*)(KB0 + (slot) * G::KBYTES + c_ * G::KPS), 16, 0, 0); } } while (0)
#define U64_DMAV(t, slot) do { const bf16_t* src_ = V + (U64_GROW(t) + lane) * vpitch; \
        _Pragma("unroll") for (int i = 0; i < NVW; ++i) { const int c_ = wv + 8 * i; if (c_ < G::NPV) \
            __builtin_amdgcn_global_load_lds((const unsigned*)(src_ + c_ * 8), (LAS unsigned*)(VB0 + (slot) * G::VBYTES + c_ * G::VPS), 16, 0, 0); } } while (0)
#define U64_WAIT_BAR(n) do { const int n_ = (n); \
        if (n_ == 0) asm volatile("s_waitcnt vmcnt(0) lgkmcnt(0)" ::: "memory"); else if (n_ == 1) asm volatile("s_waitcnt vmcnt(1) lgkmcnt(0)" ::: "memory"); \
        else if (n_ == 2) asm volatile("s_waitcnt vmcnt(2) lgkmcnt(0)" ::: "memory"); else if (n_ == 3) asm volatile("s_waitcnt vmcnt(3) lgkmcnt(0)" ::: "memory"); \
        else asm volatile("s_waitcnt vmcnt(4) lgkmcnt(0)" ::: "memory"); \
        __builtin_amdgcn_s_barrier(); asm volatile("" ::: "memory"); } while (0)
    asm volatile("s_waitcnt vmcnt(0)" ::: "memory");
    U64_DMAK(0, 0); U64_DMAV(0, 0);
    U64_DMAK(1, 1); U64_DMAV(1, 1);
    U64_WAIT_BAR(nkw + nvw);
    const int q4 = (lane & 15) >> 2, p4 = lane & 3, blk = (lane >> 4) & 1;
    int sk = 0;
    for (int j = 0; j < ntiles; ++j) {
        int issued = 0;
        if (j + 2 < ntiles) { const int s2 = sk == 0 ? 2 : sk - 1; U64_DMAK(j + 2, s2); U64_DMAV(j + 2, s2); issued = nkw + nvw; }
        if (j <= last_active) {
            const lds_cptr kp = KB0 + sk * G::KBYTES + hi * G::KPS + r32 * 16;
            const lds_cptr vp = VB0 + sk * G::VBYTES + (2 * blk + (p4 >> 1)) * G::VPS + (4 * hi + q4) * 16 + 8 * (p4 & 1);
            f32x16 a0, a1, b0, b1;
            bf16x8 ka[2][2]; ka[0][0] = *(const LAS bf16x8*)(kp); ka[0][1] = *(const LAS bf16x8*)(kp + 512);
#pragma unroll
            for (int ds = 0; ds < NDS; ++ds) {
                if (ds + 1 < NDS) { ka[(ds + 1) & 1][0] = *(const LAS bf16x8*)(kp + (ds + 1) * 2 * G::KPS); ka[(ds + 1) & 1][1] = *(const LAS bf16x8*)(kp + (ds + 1) * 2 * G::KPS + 512); }
                if (ds == 0) { a0 = MFMA32(ka[0][0], qA[0], nz); a1 = MFMA32(ka[0][1], qA[0], nz); b0 = MFMA32(ka[0][0], qB[0], nz); b1 = MFMA32(ka[0][1], qB[0], nz); }
                else { a0 = MFMA32(ka[ds & 1][0], qA[ds], a0); a1 = MFMA32(ka[ds & 1][1], qA[ds], a1); b0 = MFMA32(ka[ds & 1][0], qB[ds], b0); b1 = MFMA32(ka[ds & 1][1], qB[ds], b1); }
                __builtin_amdgcn_sched_barrier(0);
            }
            if (j == 0 || j == last_active) { const int kvbase = (j == 0) ? 0 : 64 * (j - 1); const int limA = (j == 0) ? 15 : sA, limB = (j == 0) ? 15 : sB;
#pragma unroll
                for (int i = 0; i < 16; ++i) { const int kv = kvbase + crow(i, hi);
                    if (kv > limA) a0[i] = -1e30f; if (kv + 32 > limA) a1[i] = -1e30f; if (kv > limB) b0[i] = -1e30f; if (kv + 32 > limB) b1[i] = -1e30f; } }
            max_rescale<64, false>(a0, a1, mA, lA, oA, nz, lane, false);
            max_rescale<64, false>(b0, b1, mB, lB, oB, nz, lane, false);
            s16x4 vlo[2][ND0], vhi[2][ND0];
#pragma unroll
            for (int d0 = 0; d0 < ND0; ++d0) { vlo[0][d0] = vtr(vp + d0 * 4 * G::VPS); vhi[0][d0] = vtr(vp + d0 * 4 * G::VPS + 128); }
#pragma unroll
            for (int i = 0; i < 16; ++i) { a0[i] = __builtin_amdgcn_exp2f(a0[i] - mA); a1[i] = __builtin_amdgcn_exp2f(a1[i] - mA); b0[i] = __builtin_amdgcn_exp2f(b0[i] - mB); b1[i] = __builtin_amdgcn_exp2f(b1[i] - mB); }
            __builtin_amdgcn_sched_barrier(0);
            float lsA = 0.f, lsB = 0.f;
#pragma unroll
            for (int c = 0; c < 4; ++c) {
                if (c + 1 < 4) {
#pragma unroll
                    for (int d0 = 0; d0 < ND0; ++d0) { vlo[(c + 1) & 1][d0] = vtr(vp + d0 * 4 * G::VPS + (c + 1) * 256); vhi[(c + 1) & 1][d0] = vtr(vp + d0 * 4 * G::VPS + (c + 1) * 256 + 128); }
                }
                const f32x16& ca = (c >> 1) == 0 ? a0 : a1; const f32x16& cb = (c >> 1) == 0 ? b0 : b1; const int s = c & 1;
                const bf16x8 pkA = pack8(ca, s), pkB = pack8(cb, s);
                lsA += ((ca[8 * s] + ca[8 * s + 1]) + (ca[8 * s + 2] + ca[8 * s + 3])) + ((ca[8 * s + 4] + ca[8 * s + 5]) + (ca[8 * s + 6] + ca[8 * s + 7]));
                lsB += ((cb[8 * s] + cb[8 * s + 1]) + (cb[8 * s + 2] + cb[8 * s + 3])) + ((cb[8 * s + 4] + cb[8 * s + 5]) + (cb[8 * s + 6] + cb[8 * s + 7]));
#pragma unroll
                for (int d0 = 0; d0 < ND0; ++d0) {
                    const bf16x8 vf = __builtin_shufflevector(vlo[c & 1][d0], vhi[c & 1][d0], 0, 1, 2, 3, 4, 5, 6, 7);
                    oA[d0] = MFMA32(vf, pkA, oA[d0]); oB[d0] = MFMA32(vf, pkB, oB[d0]);
                }
                __builtin_amdgcn_sched_barrier(0);
            }
            lA += lsA; lB += lsB;
        }
        sk = sk == 2 ? 0 : sk + 1;
        U64_WAIT_BAR(issued);
    }
    asm volatile("s_waitcnt vmcnt(0)" ::: "memory");
#undef U64_GROW
#undef U64_DMAK
#undef U64_DMAV
#undef U64_WAIT_BAR
    const float liA = 1.0f / pair_sum_(lA, lane), liB = 1.0f / pair_sum_(lB, lane);
    bf16_t* dA = T.AOA + (size_t)(xrow0 + sA) * 512 + h * 64 + 4 * hi; bf16_t* dB = T.AOA + (size_t)(xrow0 + sB) * 512 + h * 64 + 4 * hi;
#pragma unroll
    for (int d0 = 0; d0 < 2; ++d0)
#pragma unroll
        for (int g = 0; g < 4; ++g) {
            uint2 wa; wa.x = cvt_pk_bf16(oA[d0][4 * g] * liA, oA[d0][4 * g + 1] * liA); wa.y = cvt_pk_bf16(oA[d0][4 * g + 2] * liA, oA[d0][4 * g + 3] * liA);
            uint2 wb; wb.x = cvt_pk_bf16(oB[d0][4 * g] * liB, oB[d0][4 * g + 1] * liB); wb.y = cvt_pk_bf16(oB[d0][4 * g + 2] * liB, oB[d0][4 * g + 3] * liB);
            *(uint2*)(dA + 32 * d0 + 8 * g) = wa; *(uint2*)(dB + 32 * d0 + 8 * g) = wb; }
}
__device__ __forceinline__ void diff_unit(lds_ptr lds, int wave, const Tensors& T, int b, int h, int qb, bool isx) {
    const int tid = fresh_tid(wave), lane = tid & 63, r32 = lane & 31, hi = lane >> 5, w = wave;
    int qrow, qs, qlim_meta, wave_last_s, ntiles, xrow0 = b * SEQ;
    if (isx) { qs = 256 * qb + 32 * w + r32; qrow = xrow0 + qs; qlim_meta = 15; wave_last_s = 256 * qb + 32 * w + 31; ntiles = 1 + 4 * (qb + 1); }
    else { qs = -1; qrow = M0 + 32 * w + r32; qlim_meta = r32 < 15 ? r32 : 15; wave_last_s = -1; ntiles = 1; if (w > 0) qlim_meta = 15; }
    f32x16 o2[4]; float linv2;
    f32x4* sp = (f32x4*)(T.o1scr) + tid;
    {
        f32x16 o1[4]; float linv1;
        attn_pass<64, 128>(lds, wave, T.QD + (2 * h) * 64, 512, qrow, T.KD + (2 * h) * 64, 512, T.VD + h * 128, 512, xrow0, ntiles, qlim_meta, qs, wave_last_s, o1, linv1);
#pragma unroll
        for (int d0 = 0; d0 < 4; ++d0)
#pragma unroll
            for (int g = 0; g < 4; ++g) sp[(d0 * 4 + g) * 512] = (f32x4){o1[d0][4 * g] * linv1, o1[d0][4 * g + 1] * linv1, o1[d0][4 * g + 2] * linv1, o1[d0][4 * g + 3] * linv1};
    }
    attn_pass<64, 128>(lds, wave, T.QD + (2 * h + 1) * 64, 512, qrow, T.KD + (2 * h + 1) * 64, 512, T.VD + h * 128, 512, xrow0, ntiles, qlim_meta, qs, wave_last_s, o2, linv2);
    const float lam2 = T.lam * linv2; float ss = 0.f;
    f32x16 o1[4];
#pragma unroll
    for (int d0 = 0; d0 < 4; ++d0)
#pragma unroll
        for (int g = 0; g < 4; ++g) { const f32x4 t = sp[(d0 * 4 + g) * 512]; o1[d0][4 * g] = t[0]; o1[d0][4 * g + 1] = t[1]; o1[d0][4 * g + 2] = t[2]; o1[d0][4 * g + 3] = t[3]; }
#pragma unroll
    for (int d0 = 0; d0 < 4; ++d0)
#pragma unroll
        for (int i = 0; i < 16; ++i) { const float d = o1[d0][i] - lam2 * o2[d0][i]; o1[d0][i] = d; ss += d * d; }
    ss += shx(ss, 32, lane);
    const float rs = rsqrtf(ss * (1.0f / 128.0f) + EPS) * (1.0f - T.lam_init);
    bf16_t* dst = T.AOB + (size_t)qrow * 512 + h * 128 + 4 * hi;
#pragma unroll
    for (int d0 = 0; d0 < 4; ++d0)
#pragma unroll
        for (int g = 0; g < 4; ++g) { const f32x4 sg = *(const f32x4*)(T.subln + 32 * d0 + 8 * g + 4 * hi);
            uint2 wv; wv.x = cvt_pk_bf16(o1[d0][4 * g] * rs * sg[0], o1[d0][4 * g + 1] * rs * sg[1]); wv.y = cvt_pk_bf16(o1[d0][4 * g + 2] * rs * sg[2], o1[d0][4 * g + 3] * rs * sg[3]);
            *(uint2*)(dst + 32 * d0 + 8 * g) = wv; }
}
__device__ __forceinline__ void attn_phase(lds_ptr lds, int wave, const Tensors& T, int vcu_, int G_) {
    const int vcu = launder_s(vcu_), G = launder_s(G_);
    for (int v = vcu; v < 256; v += G) {
        { const int bh = v >> 3, s = v & 7;
#ifndef NO_DIFF
          diff_unit(lds, wave, T, bh >> 2, bh & 3, s, true); diff_unit(lds, wave, T, bh >> 2, bh & 3, 15 - s, true);
#endif
        }
        { const int bh = v >> 2, s = v & 3;
#ifndef NO_MLA
          mla_unit64(lds, wave, T, bh >> 3, bh & 7, s); mla_unit64(lds, wave, T, bh >> 3, bh & 7, 7 - s);
#endif
        }
#ifndef NO_MLA
        if (v < 8) mla_unit(lds, wave, T, 0, v, 0, false);
#endif
#ifndef NO_DIFF
        if (v >= 8 && v < 12) diff_unit(lds, wave, T, 0, v - 8, 0, false);
#endif
    }
}
}

#define XB_TMO      128
#define XB_XCNT(j)  (256  + 64 * (j))
#define XB_XSUB(j)  (1280 + 64 * (j))
#define XB_XGEN(j)  (2304 + 64 * (j))
#define XB_TOP      3328
#define XB_TOPGEN   3392
#define XCD_BAR_WORDS 3456
#define XB_SPIN_CAP (1u << 18)

__device__ __forceinline__ unsigned xb_ld(unsigned* p)              { return __hip_atomic_load(p, __ATOMIC_RELAXED, __HIP_MEMORY_SCOPE_AGENT); }
__device__ __forceinline__ unsigned xb_add(unsigned* p, unsigned v) { return __hip_atomic_fetch_add(p, v, __ATOMIC_RELAXED, __HIP_MEMORY_SCOPE_AGENT); }
__device__ __forceinline__ unsigned xb_xcc_id() { return (unsigned)__builtin_amdgcn_s_getreg((3 << 11) | 20) & 0xFu; }
#define XB_SPIN(cond, bar) do { unsigned _sp = 0; while (cond) { __builtin_amdgcn_s_sleep(1); \
    if ((++_sp & 255u) == 0u) { if (xb_ld(&(bar)[XB_TMO])) break; if (_sp > XB_SPIN_CAP) { atomicAdd(&(bar)[XB_TMO], 1u); break; } } } } while (0)

struct XcdBarrier { unsigned* bar; unsigned x; volatile LAS unsigned* st; };
__device__ __forceinline__ XcdBarrier xcd_barrier_post(unsigned* bar, volatile LAS unsigned* st, int tid) {
    XcdBarrier b; b.bar = bar; b.x = xb_xcc_id(); b.st = st;
    if (tid == 0) (void)xb_add(&bar[XB_XCNT(b.x)], 1u);
    return b;
}
__device__ __forceinline__ void xcd_barrier_complete(unsigned* bar, unsigned x, unsigned& nloc, unsigned& nx) {
    const unsigned G = gridDim.x * gridDim.y * gridDim.z;
    unsigned sum, cnt, mine, sp = 0u;
    for (;;) {
        sum = 0u; cnt = 0u; mine = 0u;
#pragma unroll
        for (unsigned j = 0; j < 16; ++j) { const unsigned c = xb_ld(&bar[XB_XCNT(j)]); sum += c; cnt += (c > 0u) ? 1u : 0u; mine = (j == x) ? c : mine; }
        if (sum == G) break;
        __builtin_amdgcn_s_sleep(1);
        if ((++sp & 255u) == 0u) { if (xb_ld(&bar[XB_TMO])) break; if (sp > XB_SPIN_CAP) { atomicAdd(&bar[XB_TMO], 1u); break; } }
    }
    nloc = mine > 0u ? mine : 1u; nx = cnt > 0u ? cnt : 1u;
}

__device__ __forceinline__ void xcd_barrier(const XcdBarrier& b, int tid) {
    asm volatile("s_waitcnt vmcnt(0)" ::: "memory");
    __syncthreads();
    if (tid == 0) {
        unsigned* bar = b.bar;
        __builtin_amdgcn_s_waitcnt(0);
        unsigned nloc = b.st[0], nx = b.st[1];
        if (nloc == 0u) { xcd_barrier_complete(bar, b.x, nloc, nx); b.st[0] = nloc; b.st[1] = nx; }
        const unsigned old = xb_add(&bar[XB_XSUB(b.x)], 1u);
        const unsigned gen = old / nloc;
        if (old + 1u == (gen + 1u) * nloc) {
            __builtin_amdgcn_fence(__ATOMIC_RELEASE, "agent");
            asm volatile("s_waitcnt vmcnt(0)" ::: "memory");
            const unsigned og = xb_add(&bar[XB_TOP], 1u);
            const unsigned tg = og / nx;
            if (og + 1u == (tg + 1u) * nx) xb_add(&bar[XB_TOPGEN], 1u);
            else XB_SPIN(xb_ld(&bar[XB_TOPGEN]) == tg, bar);
            __builtin_amdgcn_fence(__ATOMIC_ACQUIRE, "agent");
            xb_add(&bar[XB_XGEN(b.x)], 1u);
            asm volatile("s_waitcnt vmcnt(0)" ::: "memory");
        } else {
            XB_SPIN(xb_ld(&bar[XB_XGEN(b.x)]) == gen, bar);
            __builtin_amdgcn_fence(__ATOMIC_ACQUIRE, "agent");
            asm volatile("s_waitcnt vmcnt(0)" ::: "memory");
        }
    }
    __syncthreads();
}

enum { WK_ID = 0, WK_INA, WK_INB, WK_UQ, WK_UKV, WK_GU };
__device__ __forceinline__ int src_col(int kind, int n) {
    switch (kind) {
    case WK_INA: {
        if (n < 1024) { const int seg = n >> 9, g = (n & 511) >> 6, j = n & 63; const int t = j < 16 ? ((j & 1) ? 8 + (j >> 1) : (j >> 1)) : j; return (seg == 0 ? 672 : 1184) + 64 * g + t; }
        if (n < 1536) return 1696 + (n - 1024);
        if (n < 1792) return 384 + (n - 1536);
        if (n < 2176) return n - 1792;
        if (n < 2208) { const int j = n - 2176; return 640 + ((j & 1) ? 16 + (j >> 1) : (j >> 1)); }
        return -1; }
    case WK_INB: return 2208 + n;
    case WK_UQ: { const int hd = n / 96, j = n % 96; if (j < 64) return n; const int jj = j - 64; return hd * 96 + 64 + ((jj & 1) ? 16 + (jj >> 1) : (jj >> 1)); }
    case WK_UKV: { if (n < 512) return (n >> 6) * 128 + (n & 63); const int nn = n - 512; return (nn >> 6) * 128 + 64 + (nn & 63); }
    case WK_GU: { const int t = n >> 8, c = n & 255; return c < 128 ? 128 * t + c : DFF + 128 * t + (c - 128); }
    default: return n;
    }
}
__device__ __forceinline__ void transpose_item(const float* __restrict__ W, int K, int N, const float* __restrict__ gain, bf16_t* WT, int kind, LAS float* scr, int item, int lane) {
    const int kblk = K / 64, nb = item / kblk, kb = item % kblk, k0 = 64 * kb, n0 = 32 * nb;
    const int s0 = src_col(kind, n0), base = s0 & ~31;
    f32x4 v[8];
    const int c4 = lane & 7, kr = lane >> 3;
    if (s0 >= 0) {
#pragma unroll
        for (int i = 0; i < 8; ++i) v[i] = *(const f32x4*)(W + (size_t)(k0 + kr + 8 * i) * N + base + 4 * c4);
        if (gain) {
#pragma unroll
            for (int i = 0; i < 8; ++i) v[i] = v[i] * gain[k0 + kr + 8 * i];
        }
    } else {
#pragma unroll
        for (int i = 0; i < 8; ++i) v[i] = (f32x4){0.f, 0.f, 0.f, 0.f};
    }
#pragma unroll
    for (int i = 0; i < 8; ++i) { LAS float* d = scr + (kr + 8 * i) * 33 + 4 * c4; d[0] = v[i][0]; d[1] = v[i][1]; d[2] = v[i][2]; d[3] = v[i][3]; }
    asm volatile("s_waitcnt lgkmcnt(0)" ::: "memory");
    const int c = lane & 7;
#pragma unroll
    for (int j = 0; j < 4; ++j) { const int n = (lane >> 3) + 8 * j; const int sc = s0 >= 0 ? src_col(kind, n0 + n) - base : n; const LAS float* s = scr + (8 * c) * 33 + sc;
        u32x4 o; o.x = pk2(s[0 * 33], s[1 * 33]); o.y = pk2(s[2 * 33], s[3 * 33]); o.z = pk2(s[4 * 33], s[5 * 33]); o.w = pk2(s[6 * 33], s[7 * 33]);
        *(u32x4*)(WT + (size_t)(n0 + n) * K + k0 + 8 * c) = o; }
    asm volatile("s_waitcnt lgkmcnt(0)" ::: "memory");
}
struct WDesc { int in_idx, K, N, Np, kind, gain_idx; size_t off; };
__device__ __forceinline__ WDesc wdesc(int i) {
    switch (i) {
    case 0: return WDesc{I_WIN, 1024, 4256, 2304, WK_INA, -1, WO_INA};
    case 1: return WDesc{I_WIN, 1024, 4256, 2048, WK_INB, -1, WO_INB};
    case 2: return WDesc{I_WUQ, 384, 768, 768, WK_UQ, I_QNORM, WO_UQ};
    case 3: return WDesc{I_WUKV, 256, 1024, 1024, WK_UKV, I_KVNORM, WO_UKV};
    case 4: return WDesc{I_WOMLA, 512, 1024, 1024, WK_ID, -1, WO_OMLA};
    case 5: return WDesc{I_WODIFF, 512, 1024, 1024, WK_ID, -1, WO_ODIFF};
    case 6: return WDesc{I_WOUT, 1024, 1024, 1024, WK_ID, -1, WO_OUT};
    case 7: return WDesc{I_WGU, 1024, 5632, 5632, WK_GU, -1, WO_GU};
    default: return WDesc{I_WDOWN, 2816, 1024, 1024, WK_ID, -1, WO_DOWN};
    }
}
__device__ __forceinline__ void wave_sum4(float (&s)[4], int lane) {
#pragma unroll
    for (int o = 1; o < 64; o <<= 1) {
        float t[4];
#pragma unroll
        for (int r = 0; r < 4; ++r) t[r] = shx(s[r], o, lane);
#pragma unroll
        for (int r = 0; r < 4; ++r) s[r] += t[r];
    }
}
__device__ __forceinline__ void row_pass(int gw_, int ngw_, int wave_, int nrows, const float* rin_x, const float* rin_m, const bf16_t* mix, const float* gpost, const bf16_t* mix2, const float* gpost2, float* rout_x, float* rout_m, const float* gnext, bf16_t* XN) {
    const int lane = fresh_tid(wave_) & 63; const int gw = launder_s(gw_), ngw = launder_s(ngw_);
    static_assert(M0 % 4 == 0 && MVALID % 4 == 0 && MP % 4 == 0, "row groups of 4 never straddle a buffer boundary");
    for (int g = gw; g < nrows / 4; g += ngw) {
        const int row0 = 4 * g;
        if (row0 >= MVALID) { if (XN) {
#pragma unroll
                for (int r = 0; r < 4; ++r) { unsigned long long* o8 = (unsigned long long*)(XN + (size_t)(row0 + r) * DM) + lane;
#pragma unroll
                    for (int j = 0; j < 4; ++j) o8[64 * j] = 0ull; } } continue; }
        const float* rp = row0 < M0 ? rin_x + (size_t)row0 * DM : rin_m + (size_t)(row0 - M0) * DM;
        f32x4 v[4][4];
#pragma unroll
        for (int r = 0; r < 4; ++r)
#pragma unroll
            for (int j = 0; j < 4; ++j) v[r][j] = ((const f32x4*)(rp + (size_t)r * DM))[lane + 64 * j];
        if (mix) {
            uint2 mw[4][4];
#pragma unroll
            for (int r = 0; r < 4; ++r)
#pragma unroll
                for (int j = 0; j < 4; ++j) mw[r][j] = ((const uint2*)(mix + (size_t)(row0 + r) * DM))[lane + 64 * j];
            f32x4 gp[4];
#pragma unroll
            for (int j = 0; j < 4; ++j) gp[j] = ((const f32x4*)gpost)[lane + 64 * j];
            float s[4];
#pragma unroll
            for (int r = 0; r < 4; ++r) { s[r] = 0.f;
#pragma unroll
                for (int j = 0; j < 4; ++j) { const f32x4 m4 = (f32x4){bflo(mw[r][j].x), bfhi(mw[r][j].x), bflo(mw[r][j].y), bfhi(mw[r][j].y)}; s[r] += sumsq4(m4); } }
            wave_sum4(s, lane);
#pragma unroll
            for (int r = 0; r < 4; ++r) { const float rs = rsqrtf(s[r] * (1.0f / DM) + EPS);
#pragma unroll
                for (int j = 0; j < 4; ++j) { const f32x4 m4 = (f32x4){bflo(mw[r][j].x), bfhi(mw[r][j].x), bflo(mw[r][j].y), bfhi(mw[r][j].y)}; v[r][j] = v[r][j] + m4 * rs * gp[j]; } }
        }
        if (mix2) {
            uint2 mw[4][4];
#pragma unroll
            for (int r = 0; r < 4; ++r)
#pragma unroll
                for (int j = 0; j < 4; ++j) mw[r][j] = ((const uint2*)(mix2 + (size_t)(row0 + r) * DM))[lane + 64 * j];
            f32x4 gp[4];
#pragma unroll
            for (int j = 0; j < 4; ++j) gp[j] = ((const f32x4*)gpost2)[lane + 64 * j];
            float s[4];
#pragma unroll
            for (int r = 0; r < 4; ++r) { s[r] = 0.f;
#pragma unroll
                for (int j = 0; j < 4; ++j) { const f32x4 m4 = (f32x4){bflo(mw[r][j].x), bfhi(mw[r][j].x), bflo(mw[r][j].y), bfhi(mw[r][j].y)}; s[r] += sumsq4(m4); } }
            wave_sum4(s, lane);
#pragma unroll
            for (int r = 0; r < 4; ++r) { const float rs = rsqrtf(s[r] * (1.0f / DM) + EPS);
#pragma unroll
                for (int j = 0; j < 4; ++j) { const f32x4 m4 = (f32x4){bflo(mw[r][j].x), bfhi(mw[r][j].x), bflo(mw[r][j].y), bfhi(mw[r][j].y)}; v[r][j] = v[r][j] + m4 * rs * gp[j]; } }
        }
        if (rout_x) { float* op = row0 < M0 ? rout_x + (size_t)row0 * DM : rout_m + (size_t)(row0 - M0) * DM;
#pragma unroll
            for (int r = 0; r < 4; ++r)
#pragma unroll
                for (int j = 0; j < 4; ++j) ((f32x4*)(op + (size_t)r * DM))[lane + 64 * j] = v[r][j]; }
        if (XN) { float s[4];
#pragma unroll
            for (int r = 0; r < 4; ++r) { s[r] = 0.f;
#pragma unroll
                for (int j = 0; j < 4; ++j) s[r] += sumsq4(v[r][j]); }
            wave_sum4(s, lane);
            f32x4 gn[4];
#pragma unroll
            for (int j = 0; j < 4; ++j) gn[j] = ((const f32x4*)gnext)[lane + 64 * j];
#pragma unroll
            for (int r = 0; r < 4; ++r) { const float rs = rsqrtf(s[r] * (1.0f / DM) + EPS); unsigned long long* o8 = (unsigned long long*)(XN + (size_t)(row0 + r) * DM) + lane;
#pragma unroll
                for (int j = 0; j < 4; ++j) { const f32x4 y = v[r][j] * rs * gn[j];
                    o8[64 * j] = (unsigned long long)cvt_pk_bf16(y[0], y[1]) | ((unsigned long long)cvt_pk_bf16(y[2], y[3]) << 32); } } }
    }
}

constexpr int LDS_BYTES = 131072 + 1024;
static_assert(att::LDS_NEED <= 131072, "attention LDS");
__global__ void __launch_bounds__(512, 2) fwd_megakernel(Params p) {
    extern __shared__ __attribute__((aligned(16))) unsigned char lds_raw[];
    LAS unsigned char* lds = (LAS unsigned char*)lds_raw;
    cg::grid_group grid = cg::this_grid();
    const int wave = __builtin_amdgcn_readfirstlane((int)threadIdx.x >> 6);
    const int G = gridDim.x, bx = blockIdx.x, vcu = (G % 8 == 0) ? (bx % 8) * (G / 8) + bx / 8 : bx;
    const int gw = vcu * 8 + wave, ngw = G * 8;
    { const int t0 = fresh_tid(wave); if (t0 < 64) ((LAS unsigned*)(lds + 131072))[t0] = 0u; __syncthreads(); }
    const XcdBarrier xbar = xcd_barrier_post((unsigned*)(p.ws + WS_BAR), (volatile LAS unsigned*)(lds + 131072 + 32), fresh_tid(wave));
#define GRID_BAR() xcd_barrier(xbar, fresh_tid(wave))
#define WSP() ({ unsigned char* w__ = p.ws; asm volatile("" : "+s"(w__)); w__; })
#define B16(w, off) ((bf16_t*)((w) + (off)))
    {
        unsigned char* ws = WSP();
        float* lamp = (float*)(ws + WS_LAM); float* rope = (float*)(ws + WS_ROPE);
        LAS float* scr = (LAS float*)(lds + wave * 16384);
        const int tid = fresh_tid(wave), lane = tid & 63;
        for (int L = 0; L < NLAYER; ++L)
            for (int wi = 0; wi < 9; ++wi) {
                const WDesc d = wdesc(wi);
                const float* W = p.in[d.in_idx] + (size_t)L * d.K * d.N;
                const float* gain = d.gain_idx >= 0 ? p.in[d.gain_idx] + (size_t)L * d.K : nullptr;
                bf16_t* WT = (bf16_t*)(ws + WS_W + L * WS_WSTRIDE + d.off);
                const int nitems = (d.Np / 32) * (d.K / 64);
                for (int it = gw; it < nitems; it += ngw) transpose_item(W, d.K, d.N, gain, WT, d.kind, scr, it, lane);
            }
        for (int i = bx * 512 + tid; i < NPOS * 24; i += G * 512) { const int pos = i / 24, f = i % 24; const double rev = (double)pos * p.invrev[f]; const float fr = (float)(rev - floor(rev));
            rope[2 * i] = __builtin_amdgcn_cosf(fr); rope[2 * i + 1] = __builtin_amdgcn_sinf(fr); }
        if (launder_s(bx) == 0 && launder_s(wave) == 0) {
            for (int L = 0; L < NLAYER; ++L) { const float* lp = p.in[I_LAMBDA] + L * 256;
                const float a = wave_sum(lp[lane] * lp[64 + lane], lane), b = wave_sum(lp[128 + lane] * lp[192 + lane], lane);
                const float lam_init = L == 0 ? 0.2f : 0.35550906759096924f;
                if (lane == 0) lamp[L] = expf(a) - expf(b) + lam_init; }
        }
        row_pass(gw, ngw, wave, MP, p.in[I_X], p.in[I_META], nullptr, nullptr, nullptr, nullptr, nullptr, nullptr, p.in[I_NMIXPRE], B16(ws, WS_XN));
    }
    grid.sync();

    for (int L = 0; L < NLAYER; ++L) {
        const size_t wlo = WS_W + L * WS_WSTRIDE;
        const size_t sqo = WS_SSQQ, skvo = WS_SSQKV;
        const int Mpost = (L + 1 < NLAYER) ? MP : M0;
        { unsigned char* ws = WSP();
          EpiInA E{B16(ws, WS_QD), B16(ws, WS_KD), B16(ws, WS_VD), B16(ws, WS_KVL), B16(ws, WS_QL), B16(ws, WS_KA), (float*)(ws + sqo), (float*)(ws + skvo), (const float*)(ws + WS_ROPE)};
          run_gemm<0>(lds, wave, gw, B16(ws, WS_XN), B16(ws, wlo + WO_INA), 2304, 1024, E); }
        GRID_BAR();
        { unsigned char* ws = WSP(); EpiQA E{B16(ws, WS_QA), (const float*)(ws + sqo), (const float*)(ws + WS_ROPE)}; run_gemm<1>(lds, wave, gw, B16(ws, WS_QL), B16(ws, wlo + WO_UQ), 768, 384, E); }
        { unsigned char* ws = WSP(); EpiKV E{B16(ws, WS_KA), B16(ws, WS_VA), (const float*)(ws + skvo)}; run_gemm<2>(lds, wave, gw, B16(ws, WS_KVL), B16(ws, wlo + WO_UKV), 1024, 256, E); }
        GRID_BAR();
        { unsigned char* ws = WSP();
          att::Tensors T{B16(ws, WS_QA), B16(ws, WS_KA), B16(ws, WS_VA), B16(ws, WS_QD), B16(ws, WS_KD), B16(ws, WS_VD), B16(ws, WS_AOA), B16(ws, WS_AOB), p.in[I_SUBLN] + L * 128, ((const float*)(ws + WS_LAM))[L], L == 0 ? 0.2f : 0.35550906759096924f, (float*)(ws + WS_O1 + (size_t)bx * 131072)};
          att::attn_phase((att::lds_ptr)lds, wave, T, vcu, G);
#ifdef PROBE_ATT2
          att::attn_phase((att::lds_ptr)lds, wave, T, vcu, G);
#endif
        }
        GRID_BAR();
        if (Mpost == MP) {
            { unsigned char* ws = WSP(); EpiGate E{B16(ws, WS_G), 0}; mini_gemm(lds, wave, B16(ws, WS_XN), B16(ws, wlo + WO_INB), 1024, 1024, E); }
            { unsigned char* ws = WSP(); EpiGate E{B16(ws, WS_G), 1024}; mini_gemm(lds, wave, B16(ws, WS_XN), B16(ws, wlo + WO_INB) + (size_t)1024 * 1024, 1024, 1024, E); }
            { unsigned char* ws = WSP(); EpiMix<false> E{B16(ws, WS_MIXIN), B16(ws, WS_G), 0}; mini_gemm(lds, wave, B16(ws, WS_AOA), B16(ws, wlo + WO_OMLA), 1024, 512, E); }
            { unsigned char* ws = WSP(); EpiMix<true> E{B16(ws, WS_MIXIN), B16(ws, WS_G), 1024}; mini_gemm(lds, wave, B16(ws, WS_AOB), B16(ws, wlo + WO_ODIFF), 1024, 512, E); }
        }
        { unsigned char* ws = WSP(); EpiGate E{B16(ws, WS_G), 0}; run_gemm_pair(lds, wave, B16(ws, WS_XN), B16(ws, wlo + WO_INB), 1024, E, 0); }
        { unsigned char* ws = WSP(); EpiMixPair E{B16(ws, WS_MIXIN), B16(ws, WS_G)}; run_gemm_pair(lds, wave, B16(ws, WS_AOA), B16(ws, wlo + WO_OMLA), 512, E, AO_PM_OFF); }
        GRID_BAR();
        { unsigned char* ws = WSP(); EpiPlain E{B16(ws, WS_MIX), 1024}; run_gemm<7>(lds, wave, gw, B16(ws, WS_MIXIN), B16(ws, wlo + WO_OUT), 1024, 1024, E, Mpost); }
        GRID_BAR();
        { unsigned char* ws = WSP(); float* RM = (float*)(ws + WS_RM);
          row_pass(gw, ngw, wave, Mpost, L == 0 ? p.in[I_X] : p.out, L == 0 ? p.in[I_META] : RM, B16(ws, WS_MIX), p.in[I_NMIXPOST] + L * DM, nullptr, nullptr, nullptr, nullptr, p.in[I_NFFNPRE] + L * DM, B16(ws, WS_XN)); }
        GRID_BAR();
        { unsigned char* ws = WSP(); EpiSwiglu E{B16(ws, WS_FF)}; run_gemm<8>(lds, wave, gw, B16(ws, WS_XN), B16(ws, wlo + WO_GU), 5632, 1024, E, Mpost); }
        GRID_BAR();
        { unsigned char* ws = WSP(); EpiPlain E{B16(ws, WS_FFO), 1024}; run_gemm<9>(lds, wave, gw, B16(ws, WS_FF), B16(ws, wlo + WO_DOWN), 1024, DFF, E, Mpost); }
        GRID_BAR();
        { unsigned char* ws = WSP(); float* RM = (float*)(ws + WS_RM);
          const float* r0x = L == 0 ? p.in[I_X] : p.out; const float* r0m = L == 0 ? p.in[I_META] : RM;
          if (L + 1 < NLAYER) row_pass(gw, ngw, wave, MP, r0x, r0m, B16(ws, WS_MIX), p.in[I_NMIXPOST] + L * DM, B16(ws, WS_FFO), p.in[I_NFFNPOST] + L * DM, p.out, RM, p.in[I_NMIXPRE] + (L + 1) * DM, B16(ws, WS_XN));
          else row_pass(gw, ngw, wave, M0, r0x, r0m, B16(ws, WS_MIX), p.in[I_NMIXPOST] + L * DM, B16(ws, WS_FFO), p.in[I_NFFNPOST] + L * DM, p.out, RM, nullptr, nullptr); }
        if (L + 1 < NLAYER) GRID_BAR();
    }
}

extern "C" void kernel_launch(void* const* d_in, const int* in_sizes, int n_in, void* d_out, int out_size, void* d_ws, size_t ws_size, hipStream_t stream) {
    static int grid = 0;
    if (grid == 0) {
        if (n_in != 18 || ws_size < WS_END) { fprintf(stderr, "kernel_launch: unexpected n_in %d / ws_size %zu\n", n_in, ws_size); grid = -1; return; }
        int dev = 0, cus = 0, per_cu = 0;
        hipGetDevice(&dev); hipDeviceGetAttribute(&cus, hipDeviceAttributeMultiprocessorCount, dev);
        if (hipFuncSetAttribute((const void*)fwd_megakernel, hipFuncAttributeMaxDynamicSharedMemorySize, LDS_BYTES) != hipSuccess) { fprintf(stderr, "kernel_launch: hipFuncSetAttribute failed\n"); grid = -1; return; }
        if (hipOccupancyMaxActiveBlocksPerMultiprocessor(&per_cu, (const void*)fwd_megakernel, 512, LDS_BYTES) != hipSuccess || per_cu < 1) { fprintf(stderr, "kernel_launch: occupancy query gave %d\n", per_cu); per_cu = 1; }
        (void)hipGetLastError();
        grid = cus < 256 ? cus : 256;
    }
    if (grid < 0) return;
    Params p{};
    for (int i = 0; i < 18; ++i) p.in[i] = (const float*)d_in[i];
    p.out = (float*)d_out; p.ws = (unsigned char*)d_ws;
    const double TWO_PI = 6.283185307179586476925286766559;
    for (int i = 0; i < 16; ++i) p.invrev[i] = pow(500000.0, -(double)i / 16.0) / TWO_PI;
    for (int i = 0; i < 8; ++i) p.invrev[16 + i] = pow(500000.0, -(double)i / 8.0) / TWO_PI;
    if (hipMemsetAsync((char*)d_ws + WS_BAR, 0, WS_BAR_BYTES, stream) != hipSuccess) { fprintf(stderr, "kernel_launch: memset failed\n"); return; }
    void* args[] = {&p};
    hipError_t e = hipLaunchCooperativeKernel((const void*)fwd_megakernel, dim3(grid), dim3(512), args, LDS_BYTES, stream);
    if (e != hipSuccess) fprintf(stderr, "cooperative launch failed: %s (grid %d)\n", hipGetErrorString(e), grid);
}
```

```cpp
#include <hip/hip_runtime.h>
#include <hip/hip_cooperative_groups.h>
#include <cstdio>
#include <cstdint>
#include <cmath>
namespace cg = cooperative_groups;
__device__ __forceinline__ int launder(int x) { asm volatile("" : "+v"(x)); return x; }
__device__ __forceinline__ int launder_s(int x) { asm volatile("" : "+s"(x)); return x; }
__device__ __forceinline__ int fresh_tid(int wave) { int z = 0; asm volatile("" : "+s"(z)); return wave * 64 + (int)__builtin_amdgcn_mbcnt_hi(~0u, __builtin_amdgcn_mbcnt_lo(~0u, (unsigned)z)); }
__device__ __forceinline__ float shx(float v, int o, int lane) { return __builtin_bit_cast(float, __builtin_amdgcn_ds_bpermute((lane ^ o) << 2, __builtin_bit_cast(int, v))); }

namespace pg8 {
#define PG8_LAS __attribute__((address_space(3)))
typedef unsigned short bf16_t;
typedef short bf16x8 __attribute__((ext_vector_type(8)));
typedef float f32x4 __attribute__((ext_vector_type(4)));
typedef unsigned u32x4 __attribute__((ext_vector_type(4)));
constexpr int BM = 256, BK = 64, HALF = 128, HTB = HALF * BK * 2  , STAGE_BYTES = 8 * HTB, NXCD = 8, WGM = 8;

__host__ __device__ __forceinline__ int lds_byte(int r, int c) { const int st = (r >> 4) * 2 + (c >> 5), rr = r & 15, cc = c & 31, ob = rr * 64 + cc * 2; return st * 1024 + (ob ^ (((ob >> 9) & 1) << 5)); }
__host__ __device__ __forceinline__ void stage_rc(int b, int& R, int& C) { const int st = b / 1024, sb = b % 1024, swz = sb ^ (((sb >> 9) & 1) << 5); R = (st >> 1) * 16 + swz / 64; C = (st & 1) * 32 + (swz % 64) / 2; }
__host__ __device__ __forceinline__ int perm32(int rho) { const int n = rho >> 4, i = rho & 15; return 8 * (i >> 2) + 4 * n + (i & 3); }

struct Unit { int pm, pn; };
struct Gemm { const bf16_t* A; const bf16_t* Bt; int M, N, K; };

struct StaticOrder {
    int nM, nN, nwg, G, c;
    __host__ __device__ void init(int M, int N, int G_, int c_) { nM = M / BM; nN = N / BM; nwg = nM * nN; G = G_; c = c_; }
    __host__ __device__ bool next(int i, Unit& u) const {
        const long L = (long)i * G + c; if (L >= nwg) return false;
        int wgid = (int)L; { const int q = nwg / NXCD, r = nwg % NXCD, xcd = wgid % NXCD, off = wgid / NXCD; wgid = (xcd < r ? xcd * (q + 1) : r * (q + 1) + (xcd - r) * q) + off; }
        const int nig = WGM * nN, gid = wgid / nig, fm = gid * WGM, gsz = (nM - fm) < WGM ? (nM - fm) : WGM;
        u.pm = fm + ((wgid % nig) % gsz); u.pn = (wgid % nig) / gsz; return true;
    }
    __device__ __forceinline__ void a_ready(const Unit&) const {}
    __device__ __forceinline__ void done(const Unit&) const {}
};

typedef float f32x2 __attribute__((ext_vector_type(2)));
typedef __bf16 bf16x2_t __attribute__((ext_vector_type(2)));
__device__ __forceinline__ unsigned cvt_pk_bf16(float lo, float hi) { f32x2 v = {lo, hi}; bf16x2_t b = __builtin_convertvector(v, bf16x2_t); return __builtin_bit_cast(unsigned, b); }
template <class Epi, class Sched, bool ALIGN_EPI = false, bool SP2 = false>
__device__ __forceinline__ void gemm_phase(PG8_LAS unsigned char* lds, const Gemm g, const Sched& S, const Epi& E, int wave_) {
    const int tid = fresh_tid(wave_), wid = __builtin_amdgcn_readfirstlane(tid >> 6), lane = tid & 63, wr = wid >> 2, wc = wid & 3, fr = lane & 15, fq = lane >> 4;
    const int K = g.K, nt = K / BK;
    unsigned voffA[2], voffB[2];
#pragma unroll
    for (int i = 0; i < 2; ++i) { int R, C; stage_rc(tid * 16 + i * 8192, R, C); const int Rb = Epi::PERM ? ((R & ~31) + perm32(R & 31)) : R;
        voffA[i] = (unsigned)(R * K + C) * 2u; voffB[i] = (unsigned)(Rb * K + C) * 2u; }
    const size_t kstep = (size_t)(BK * 2);
    const size_t hstep = (size_t)HALF * K * 2;
    const size_t tstep = 2 * hstep;
    const unsigned ldsw = (unsigned)wid * 1024u;
    const int aoff = lds_byte(wr * 64 + fr, fq * 8), boff = lds_byte(wc * 32 + fr, fq * 8);
#define PG8_SA(b, h) (((b) * 2 + (h)) * HTB)
#define PG8_SB(b, h) ((4 + (b) * 2 + (h)) * HTB)
#define PG8_STAGE(bufoff, gbase, voff) do { _Pragma("unroll") for (int _i = 0; _i < 2; ++_i) \
        __builtin_amdgcn_global_load_lds((const unsigned*)((const char*)(gbase) + (voff)[_i]), (PG8_LAS unsigned*)(lds + (bufoff) + ldsw + _i * 8192), 16, 0, 0); } while (0)
#define PG8_LDA(dst, b, h) do { _Pragma("unroll") for (int m = 0; m < 4; ++m) _Pragma("unroll") for (int k = 0; k < 2; ++k) dst[m][k] = *(const PG8_LAS bf16x8*)(lds + PG8_SA(b, h) + aoff + m * 2048 + k * 1024); } while (0)
#define PG8_LDB(dst, b, h) do { _Pragma("unroll") for (int n = 0; n < 2; ++n) _Pragma("unroll") for (int k = 0; k < 2; ++k) dst[n][k] = *(const PG8_LAS bf16x8*)(lds + PG8_SB(b, h) + boff + n * 2048 + k * 1024); } while (0)
#define PG8_MMA(ai, bj, At, Bt) do { __builtin_amdgcn_s_setprio(1); _Pragma("unroll") for (int m = 0; m < 4; ++m) _Pragma("unroll") for (int n = 0; n < 2; ++n) _Pragma("unroll") for (int k = 0; k < 2; ++k) \
        acc[ai][bj][m][n] = __builtin_amdgcn_mfma_f32_16x16x32_bf16(Bt[n][k], At[m][k], acc[ai][bj][m][n], 0, 0, 0); __builtin_amdgcn_s_setprio(0); } while (0)
#define PG8_WAIT_V(n) asm volatile("s_waitcnt vmcnt(" #n ")" ::: "memory")
#define PG8_WAIT_L(n) asm volatile("s_waitcnt lgkmcnt(" #n ")" ::: "memory")
#define PG8_BAR __builtin_amdgcn_s_barrier()
#define PG8_SCHED __builtin_amdgcn_sched_barrier(0)
    Unit cur, nxt; int ui = 0;
    if (!S.next(0, cur)) return;
    f32x4 acc[2][2][4][2];
#pragma unroll
    for (int a = 0; a < 2; ++a)
#pragma unroll
        for (int b = 0; b < 2; ++b)
#pragma unroll
            for (int m = 0; m < 4; ++m)
#pragma unroll
                for (int n = 0; n < 2; ++n) acc[a][b][m][n] = (f32x4){0.f, 0.f, 0.f, 0.f};
    bf16x8 At[4][2], B0[2][2], B1[2][2];
    const char* cA = (const char*)g.A + (size_t)cur.pm * tstep; const char* cB = (const char*)g.Bt + (size_t)cur.pn * tstep;
    S.a_ready(cur);
    if constexpr (SP2) {
        PG8_STAGE(PG8_SB(0, 0), cB, voffB); PG8_STAGE(PG8_SB(0, 1), cB + hstep, voffB); PG8_STAGE(PG8_SA(0, 0), cA, voffA); PG8_STAGE(PG8_SA(0, 1), cA + hstep, voffA);
        if (wr == 1) PG8_BAR;
        PG8_WAIT_V(2); PG8_BAR;
        PG8_STAGE(PG8_SB(1, 0), cB + kstep, voffB); PG8_STAGE(PG8_SA(1, 0), cA + kstep, voffA); PG8_STAGE(PG8_SB(1, 1), cB + hstep + kstep, voffB);
        PG8_WAIT_V(6); PG8_BAR;
    } else {
        PG8_STAGE(PG8_SB(0, 0), cB, voffB); PG8_STAGE(PG8_SA(0, 0), cA, voffA); PG8_STAGE(PG8_SB(0, 1), cB + hstep, voffB); PG8_STAGE(PG8_SA(0, 1), cA + hstep, voffA);
        if (wr == 1) PG8_BAR;
        PG8_WAIT_V(4); PG8_BAR;
        PG8_STAGE(PG8_SB(1, 0), cB + kstep, voffB); PG8_STAGE(PG8_SA(1, 0), cA + kstep, voffA); PG8_STAGE(PG8_SB(1, 1), cB + hstep + kstep, voffB);
        PG8_WAIT_V(6); PG8_BAR;
    }
    for (;;) {
        const bool has_next = S.next(ui + 1, nxt);
        const char* nA = has_next ? (const char*)g.A + (size_t)nxt.pm * tstep : cA; const char* nB = has_next ? (const char*)g.Bt + (size_t)nxt.pn * tstep : cB;
        for (int t = 0; t < nt; t += 2) {
            const bool last = (t == nt - 2);
            const char* a1 = cA + (size_t)(t + 1) * kstep;
            const char* a2 = last ? nA : cA + (size_t)(t + 2) * kstep; const char* b2 = last ? nB : cB + (size_t)(t + 2) * kstep;
            const char* a3 = a2 + kstep; const char* b3 = b2 + kstep;
            if (last && has_next) S.a_ready(nxt);
            if constexpr (SP2) {
            PG8_LDB(B0, 0, 0); PG8_LDB(B1, 0, 1); PG8_SCHED; PG8_LDA(At, 0, 0); PG8_STAGE(PG8_SA(1, 1), a1 + hstep, voffA);
            PG8_WAIT_V(8); PG8_WAIT_L(0); PG8_BAR; PG8_MMA(0, 0, At, B0); PG8_MMA(0, 1, At, B1); PG8_BAR; PG8_SCHED;
            PG8_LDA(At, 0, 1); PG8_STAGE(PG8_SB(0, 0), b2, voffB); PG8_STAGE(PG8_SB(0, 1), b2 + hstep, voffB); PG8_STAGE(PG8_SA(0, 0), a2, voffA);
            PG8_WAIT_V(8); PG8_WAIT_L(0); PG8_BAR; PG8_MMA(1, 0, At, B0); PG8_MMA(1, 1, At, B1); PG8_BAR; PG8_SCHED;
            PG8_LDB(B0, 1, 0); PG8_LDB(B1, 1, 1); PG8_SCHED; PG8_LDA(At, 1, 0); PG8_STAGE(PG8_SA(0, 1), a2 + hstep, voffA);
            PG8_WAIT_V(8); PG8_WAIT_L(0); PG8_BAR; PG8_MMA(0, 0, At, B0); PG8_MMA(0, 1, At, B1); PG8_BAR; PG8_SCHED;
            PG8_LDA(At, 1, 1); PG8_STAGE(PG8_SB(1, 0), b3, voffB); PG8_STAGE(PG8_SB(1, 1), b3 + hstep, voffB); PG8_STAGE(PG8_SA(1, 0), a3, voffA);
            PG8_WAIT_V(8); PG8_WAIT_L(0); PG8_BAR; PG8_MMA(1, 0, At, B0); PG8_MMA(1, 1, At, B1); PG8_BAR; PG8_SCHED;
            } else {
            PG8_LDB(B0, 0, 0); PG8_SCHED; PG8_LDA(At, 0, 0); PG8_STAGE(PG8_SA(1, 1), a1 + hstep, voffA);
            PG8_WAIT_L(8); PG8_BAR; PG8_WAIT_L(0); PG8_MMA(0, 0, At, B0); PG8_BAR; PG8_SCHED;
            PG8_LDB(B1, 0, 1); PG8_STAGE(PG8_SB(0, 0), b2, voffB);
            PG8_BAR; PG8_WAIT_L(0); PG8_MMA(0, 1, At, B1); PG8_BAR;
            PG8_LDA(At, 0, 1); PG8_STAGE(PG8_SA(0, 0), a2, voffA);
            PG8_BAR; PG8_WAIT_L(0); PG8_MMA(1, 0, At, B0); PG8_BAR; PG8_SCHED;
            PG8_STAGE(PG8_SB(0, 1), b2 + hstep, voffB);
            PG8_WAIT_V(6); PG8_BAR; PG8_MMA(1, 1, At, B1); PG8_BAR;
            PG8_LDB(B0, 1, 0); PG8_SCHED; PG8_LDA(At, 1, 0); PG8_STAGE(PG8_SA(0, 1), a2 + hstep, voffA);
            PG8_WAIT_L(8); PG8_BAR; PG8_WAIT_L(0); PG8_MMA(0, 0, At, B0); PG8_BAR; PG8_SCHED;
            PG8_LDB(B1, 1, 1); PG8_STAGE(PG8_SB(1, 0), b3, voffB);
            PG8_BAR; PG8_WAIT_L(0); PG8_MMA(0, 1, At, B1); PG8_BAR;
            PG8_LDA(At, 1, 1); PG8_STAGE(PG8_SA(1, 0), a3, voffA);
            PG8_BAR; PG8_WAIT_L(0); PG8_MMA(1, 0, At, B0); PG8_BAR; PG8_SCHED;
            PG8_STAGE(PG8_SB(1, 1), b3 + hstep, voffB);
            PG8_WAIT_V(6); PG8_BAR; PG8_MMA(1, 1, At, B1); PG8_BAR;
            }
        }
        if constexpr (ALIGN_EPI) { if (wr == 0) PG8_BAR; }
        if constexpr (!Epi::AFTER_DRAIN) { E(acc, cur, wr, wc, fr, fq); S.done(cur); }
        if (!has_next) break;
#pragma unroll
        for (int a = 0; a < 2; ++a)
#pragma unroll
            for (int b = 0; b < 2; ++b)
#pragma unroll
                for (int m = 0; m < 4; ++m)
#pragma unroll
                    for (int n = 0; n < 2; ++n) acc[a][b][m][n] = (f32x4){0.f, 0.f, 0.f, 0.f};
        cur = nxt; cA = nA; cB = nB; ++ui;
        if constexpr (ALIGN_EPI) { if (wr == 1) PG8_BAR; }
    }
    PG8_WAIT_V(0);
    if constexpr (!ALIGN_EPI) { if (wr == 0) PG8_BAR; }
    PG8_BAR;
    if constexpr (Epi::AFTER_DRAIN) { E.fused(acc, cur, wr, wc, fr, fq, lds, wid, lane); S.done(cur); }
#undef PG8_SA
#undef PG8_SB
#undef PG8_STAGE
#undef PG8_LDA
#undef PG8_LDB
#undef PG8_MMA
#undef PG8_WAIT_V
#undef PG8_WAIT_L
#undef PG8_BAR
#undef PG8_SCHED
}
}

using pg8::bf16_t; using pg8::f32x4; using pg8::u32x4; using pg8::bf16x8; using pg8::Unit; using pg8::cvt_pk_bf16;
#define LAS __attribute__((address_space(3)))
constexpr int DM = 1024, NB = 8, SEQ = 4096, NMETA = 16, M0 = NB * SEQ  , MP = M0 + 256  , MVALID = M0 + NMETA;
constexpr int DFF = 2816, NLAYER = 2;
constexpr float EPS = 1e-6f, LOG2E = 1.4426950408889634f;
constexpr float MLA_QSCALE = 0.10206207261596575f * LOG2E;
constexpr float DIFF_QSCALE = 0.125f * LOG2E;
constexpr int NPOS = 4352;
enum { I_X = 0, I_META, I_NMIXPRE, I_NMIXPOST, I_NFFNPRE, I_NFFNPOST, I_WIN, I_QNORM, I_KVNORM, I_WUQ, I_WUKV, I_WOMLA, I_LAMBDA, I_SUBLN, I_WODIFF, I_WOUT, I_WGU, I_WDOWN };
constexpr size_t QMiB = 1u << 18;
constexpr size_t WS_BAR = 14 * QMiB  , WS_BAR_BYTES = 16384;
constexpr size_t WS_LAM = 0, WS_ROPE = 4096, WS_SSQQ = 4 * QMiB  , WS_SSQKV = 9 * QMiB  , WS_RM = 12 * QMiB, WS_W = 16 * QMiB, WS_WSTRIDE = 124 * QMiB;
constexpr size_t WO_INA = 0, WO_INB = 18 * QMiB, WO_UQ = 34 * QMiB, WO_UKV = 37 * QMiB, WO_OMLA = 40 * QMiB, WO_ODIFF = 44 * QMiB, WO_OUT = 48 * QMiB, WO_GU = 56 * QMiB, WO_DOWN = 100 * QMiB;
constexpr size_t WS_XN = 264 * QMiB;
constexpr size_t WS_QD = 524 * QMiB, WS_KD = 654 * QMiB, WS_VD = 784 * QMiB, WS_QA = 914 * QMiB, WS_KA = 1109 * QMiB, WS_VA = 1304 * QMiB, WS_QL = 1434 * QMiB, WS_KVL = 1532 * QMiB;
constexpr size_t WS_AOA = 1600 * QMiB, WS_AOB = 1730 * QMiB, WS_G = 524 * QMiB, WS_MIXIN = 1044 * QMiB, WS_MIX = 1304 * QMiB, WS_FF = 524 * QMiB, WS_FFO = 1600 * QMiB  ;
constexpr size_t WS_O1 = 1860 * QMiB;
constexpr size_t WS_END = 1988 * QMiB;
static_assert(WS_QD + (size_t)MP * 512 * 2 <= WS_KD && WS_KD + (size_t)MP * 512 * 2 <= WS_VD && WS_VD + (size_t)MP * 512 * 2 <= WS_QA && WS_QA + (size_t)MP * 768 * 2 <= WS_KA && WS_KA + (size_t)MP * 768 * 2 <= WS_VA, "map1");
static_assert(WS_VA + (size_t)MP * 512 * 2 <= WS_QL && WS_QL + (size_t)MP * 384 * 2 <= WS_KVL && WS_KVL + (size_t)MP * 256 * 2 <= WS_AOA && WS_AOA + (size_t)MP * 512 * 2 <= WS_AOB && WS_AOB + (size_t)MP * 512 * 2 <= WS_O1, "map2");
static_assert(WS_G + (size_t)MP * 2048 * 2 <= WS_MIXIN && WS_MIXIN + (size_t)MP * 1024 * 2 <= WS_MIX && WS_MIX + (size_t)MP * 1024 * 2 <= WS_AOA && WS_FF + (size_t)MP * DFF * 2 <= WS_MIX && WS_FFO + (size_t)MP * 1024 * 2 <= WS_O1 && WS_XN + (size_t)MP * 1024 * 2 <= WS_QD, "map3");
static_assert(WO_INA + 2304 * 1024 * 2 <= WO_INB && WO_INB + 2048 * 1024 * 2 <= WO_UQ && WO_UQ + 768 * 384 * 2 <= WO_UKV && WO_UKV + 1024 * 256 * 2 <= WO_OMLA && WO_GU + 5632 * 1024 * 2 <= WO_DOWN && WO_DOWN + 1024 * 2816 * 2 <= WS_WSTRIDE, "wmap");
static_assert(WS_W + 2 * WS_WSTRIDE <= WS_XN && WS_ROPE + (size_t)NPOS * 24 * 8 <= WS_SSQQ && WS_SSQQ + (size_t)MP * 8 * 4 <= WS_SSQKV && WS_SSQKV + (size_t)MP * 4 * 4 <= WS_RM, "map4");

struct Params { const float* in[18]; float* out; unsigned char* ws; double invrev[24]; };

__device__ __forceinline__ unsigned f2bf(float f) { unsigned u = __builtin_bit_cast(unsigned, f); return (u + 0x7fffu + ((u >> 16) & 1u)) >> 16; }
__device__ __forceinline__ unsigned pk2(float lo, float hi) { return f2bf(lo) | (f2bf(hi) << 16); }
__device__ __forceinline__ float bflo(unsigned w) { return __builtin_bit_cast(float, w << 16); }
__device__ __forceinline__ float bfhi(unsigned w) { return __builtin_bit_cast(float, w & 0xffff0000u); }
__device__ __forceinline__ void st8(bf16_t* p, f32x4 v0, f32x4 v1) {
    u32x4 w; w.x = cvt_pk_bf16(v0[0], v0[1]); w.y = cvt_pk_bf16(v0[2], v0[3]); w.z = cvt_pk_bf16(v1[0], v1[1]); w.w = cvt_pk_bf16(v1[2], v1[3]); *(u32x4*)p = w; }
__device__ __forceinline__ void ld8(const bf16_t* p, f32x4& v0, f32x4& v1) {
    const u32x4 w = *(const u32x4*)p; v0 = (f32x4){bflo(w.x), bfhi(w.x), bflo(w.y), bfhi(w.y)}; v1 = (f32x4){bflo(w.z), bfhi(w.z), bflo(w.w), bfhi(w.w)}; }
__device__ __forceinline__ float sigmoidf_(float x) { return __builtin_amdgcn_rcpf(1.0f + __builtin_amdgcn_exp2f(-x * LOG2E)); }
__device__ __forceinline__ int row_pos(int row) { return row < M0 ? NMETA + (row & (SEQ - 1)) : row - M0; }
__device__ __forceinline__ void rope4(f32x4& v0, f32x4& v1, const float* t) {
    const f32x4 c0 = *(const f32x4*)t, c1 = *(const f32x4*)(t + 4);
    float a, b;
    a = v0[0]; b = v0[1]; v0[0] = a * c0[0] - b * c0[1]; v0[1] = b * c0[0] + a * c0[1];
    a = v0[2]; b = v0[3]; v0[2] = a * c0[2] - b * c0[3]; v0[3] = b * c0[2] + a * c0[3];
    a = v1[0]; b = v1[1]; v1[0] = a * c1[0] - b * c1[1]; v1[1] = b * c1[0] + a * c1[1];
    a = v1[2]; b = v1[3]; v1[2] = a * c1[2] - b * c1[3]; v1[3] = b * c1[2] + a * c1[3];
}
__device__ __forceinline__ float sumsq4(f32x4 v) { return (v[0] * v[0] + v[1] * v[1]) + (v[2] * v[2] + v[3] * v[3]); }
__device__ __forceinline__ float wave_sum(float v, int lane) {
#pragma unroll
    for (int o = 1; o < 64; o <<= 1) v += shx(v, o, lane);
    return v;
}

typedef const f32x4 (&AccRef)[2][2][4][2];
struct EpiPlain {
    static constexpr bool PERM = true, AFTER_DRAIN = false;
    bf16_t* O; int ldc;
    __device__ __forceinline__ void operator()(AccRef acc, const Unit& u, int wr, int wc, int fr_, int fq_) const { run<false>(acc, u, wr, wc, fr_, fq_); }
    template <bool MINI> __device__ __forceinline__ void run(AccRef acc, const Unit& u, int wr, int wc, int fr_, int fq_) const {
        const int ln_ = fresh_tid(0), fr = ln_ & 15, fq = ln_ >> 4; (void)fr_; (void)fq_;
        const int row0 = u.pm * 256 + wr * 64 + fr, colw = u.pn * 256 + wc * 32 + 8 * fq;
#pragma unroll
        for (int ai = 0; ai < (MINI ? 1 : 2); ++ai)
#pragma unroll
            for (int m = 0; m < (MINI ? 1 : 4); ++m) { const int row = row0 + ai * 128 + m * 16;
#pragma unroll
                for (int bj = 0; bj < 2; ++bj) st8(O + (size_t)row * ldc + colw + bj * 128, acc[ai][bj][m][0], acc[ai][bj][m][1]); }
    }
};
struct EpiInA {
    static constexpr bool PERM = true, AFTER_DRAIN = false;
    bf16_t *QD, *KD, *VD, *KVL, *QL, *KA; float *ssq_q, *ssq_kv; const float* rope;
    template <bool MINI> static __device__ __forceinline__ void lat(AccRef acc, bf16_t* dst, int ld, float* sq, int nslot, int slot, int row0, int cw, int fr, int fq) {
#pragma unroll
        for (int ai = 0; ai < (MINI ? 1 : 2); ++ai)
#pragma unroll
            for (int m = 0; m < (MINI ? 1 : 4); ++m) { const int row = row0 + ai * 128 + m * 16; float s = 0.f;
#pragma unroll
                for (int bj = 0; bj < 2; ++bj) { const f32x4 v0 = acc[ai][bj][m][0], v1 = acc[ai][bj][m][1]; s += sumsq4(v0) + sumsq4(v1); st8(dst + (size_t)row * ld + bj * 128 + cw, v0, v1); }
                s += shx(s, 16, fr + 16 * fq); s += shx(s, 32, fr + 16 * fq);
                if (fq == 0) sq[(size_t)row * nslot + slot] = s; }
    }
    __device__ __forceinline__ void operator()(AccRef acc, const Unit& u, int wr, int wc, int fr_, int fq_) const { run<false>(acc, u, wr, wc, fr_, fq_); }
    template <bool MINI> __device__ __forceinline__ void run(AccRef acc, const Unit& u, int wr, int wc, int fr_, int fq_) const {
        const int ln_ = fresh_tid(0), fr = ln_ & 15, fq = ln_ >> 4; (void)fr_; (void)fq_;
        const int pn = u.pn, row0 = u.pm * 256 + wr * 64 + fr, cw = wc * 32 + 8 * fq;
        if (pn < 6) {
            static_assert(WS_KD - WS_QD == WS_VD - WS_KD, "QD/KD/VD equally spaced");
            bf16_t* dst = QD + (size_t)(pn >> 1) * ((WS_KD - WS_QD) / 2);
            const int cbase = (pn & 1) * 256;
            const bool dorope = (pn < 4) && ((wc & 1) == 0) && (fq < 2);
            const float sc = pn < 2 ? DIFF_QSCALE : 1.0f;
#pragma unroll
            for (int ai = 0; ai < (MINI ? 1 : 2); ++ai)
#pragma unroll
                for (int m = 0; m < (MINI ? 1 : 4); ++m) { const int row = row0 + ai * 128 + m * 16; const float* rt = rope + (size_t)row_pos(row) * 48 + 2 * (16 + 4 * fq);
#pragma unroll
                    for (int bj = 0; bj < 2; ++bj) { f32x4 v0 = acc[ai][bj][m][0], v1 = acc[ai][bj][m][1];
                        if (dorope) rope4(v0, v1, rt);
                        v0 = v0 * sc; v1 = v1 * sc; st8(dst + (size_t)row * 512 + cbase + bj * 128 + cw, v0, v1); } }
        } else if (pn == 6) { lat<MINI>(acc, KVL, 256, ssq_kv, 4, wc, row0, cw, fr, fq);
        } else if (pn == 7) { lat<MINI>(acc, QL, 384, ssq_q, 8, wc, row0, cw, fr, fq);
        } else {
#pragma unroll
            for (int ai = 0; ai < (MINI ? 1 : 2); ++ai)
#pragma unroll
                for (int m = 0; m < (MINI ? 1 : 4); ++m) { const int row = row0 + ai * 128 + m * 16;
                    { const f32x4 v0 = acc[ai][0][m][0], v1 = acc[ai][0][m][1]; float s = sumsq4(v0) + sumsq4(v1); st8(QL + (size_t)row * 384 + 256 + cw, v0, v1);
                      s += shx(s, 16, fr + 16 * fq); s += shx(s, 32, fr + 16 * fq);
                      if (fq == 0) ssq_q[(size_t)row * 8 + 4 + wc] = s; }
                    if (wc == 0) { f32x4 v0 = acc[ai][1][m][0], v1 = acc[ai][1][m][1]; rope4(v0, v1, rope + (size_t)row_pos(row) * 48 + 2 * (4 * fq));
                        u32x4 w; w.x = cvt_pk_bf16(v0[0], v0[1]); w.y = cvt_pk_bf16(v0[2], v0[3]); w.z = cvt_pk_bf16(v1[0], v1[1]); w.w = cvt_pk_bf16(v1[2], v1[3]);
#pragma unroll
                        for (int h = 0; h < 8; ++h) *(u32x4*)(KA + (size_t)row * 768 + h * 96 + 64 + 8 * fq) = w; } }
        }
    }
};
struct EpiQA {
    static constexpr bool PERM = true, AFTER_DRAIN = false;
    bf16_t* QA; const float* ssq_q; const float* rope;
    __device__ __forceinline__ void operator()(AccRef acc, const Unit& u, int wr, int wc, int fr_, int fq_) const { run<false>(acc, u, wr, wc, fr_, fq_); }
    template <bool MINI> __device__ __forceinline__ void run(AccRef acc, const Unit& u, int wr, int wc, int fr_, int fq_) const {
        const int ln_ = fresh_tid(0), fr = ln_ & 15, fq = ln_ >> 4; (void)fr_; (void)fq_;
        const int row0 = u.pm * 256 + wr * 64 + fr, colw = u.pn * 256 + wc * 32 + 8 * fq;
#pragma unroll
        for (int ai = 0; ai < (MINI ? 1 : 2); ++ai)
#pragma unroll
            for (int m = 0; m < (MINI ? 1 : 4); ++m) { const int row = row0 + ai * 128 + m * 16; const f32x4 sa = *(const f32x4*)(ssq_q + (size_t)row * 8), sb = *(const f32x4*)(ssq_q + (size_t)row * 8 + 4); const float rs = rsqrtf((((sa[0] + sa[1]) + (sa[2] + sa[3])) + ((sb[0] + sb[1]) + (sb[2] + sb[3]))) * (1.0f / 384.0f) + EPS) * MLA_QSCALE; const float* rt = rope + (size_t)row_pos(row) * 48;
#pragma unroll
                for (int bj = 0; bj < 2; ++bj) { const int col = colw + bj * 128, j = col % 96; f32x4 v0 = acc[ai][bj][m][0] * rs, v1 = acc[ai][bj][m][1] * rs;
                    if (j >= 64) rope4(v0, v1, rt + (j - 64));
                    st8(QA + (size_t)row * 768 + col, v0, v1); } }
    }
};
struct EpiKV {
    static constexpr bool PERM = true, AFTER_DRAIN = false;
    bf16_t *KA, *VA; const float* ssq_kv;
    __device__ __forceinline__ void operator()(AccRef acc, const Unit& u, int wr, int wc, int fr_, int fq_) const { run<false>(acc, u, wr, wc, fr_, fq_); }
    template <bool MINI> __device__ __forceinline__ void run(AccRef acc, const Unit& u, int wr, int wc, int fr_, int fq_) const {
        const int ln_ = fresh_tid(0), fr = ln_ & 15, fq = ln_ >> 4; (void)fr_; (void)fq_;
        const int row0 = u.pm * 256 + wr * 64 + fr, colw = u.pn * 256 + wc * 32 + 8 * fq;
#pragma unroll
        for (int ai = 0; ai < (MINI ? 1 : 2); ++ai)
#pragma unroll
            for (int m = 0; m < (MINI ? 1 : 4); ++m) { const int row = row0 + ai * 128 + m * 16; const f32x4 sa = *(const f32x4*)(ssq_kv + (size_t)row * 4); const float rs = rsqrtf(((sa[0] + sa[1]) + (sa[2] + sa[3])) * (1.0f / 256.0f) + EPS);
#pragma unroll
                for (int bj = 0; bj < 2; ++bj) { const int c = colw + bj * 128; const f32x4 v0 = acc[ai][bj][m][0] * rs, v1 = acc[ai][bj][m][1] * rs;
                    bf16_t* dst = (u.pn < 2) ? KA + (size_t)row * 768 + (c >> 6) * 96 + (c & 63) : VA + (size_t)row * 512 + (c - 512);
                    st8(dst, v0, v1); } }
    }
};
struct EpiGate {
    static constexpr bool PERM = true, AFTER_DRAIN = false;
    bf16_t* G; int goff;
    __device__ __forceinline__ void operator()(AccRef acc, const Unit& u, int wr, int wc, int fr_, int fq_) const { run<false>(acc, u, wr, wc, fr_, fq_); }
    template <bool MINI> __device__ __forceinline__ void run(AccRef acc, const Unit& u, int wr, int wc, int fr_, int fq_) const {
        const int ln_ = fresh_tid(0), fr = ln_ & 15, fq = ln_ >> 4; (void)fr_; (void)fq_;
        const int row0 = u.pm * 256 + wr * 64 + fr, colw = u.pn * 256 + wc * 32 + 8 * fq;
#pragma unroll
        for (int ai = 0; ai < (MINI ? 1 : 2); ++ai)
#pragma unroll
            for (int m = 0; m < (MINI ? 1 : 4); ++m) { const int row = row0 + ai * 128 + m * 16;
#pragma unroll
                for (int bj = 0; bj < 2; ++bj) { f32x4 v0 = acc[ai][bj][m][0], v1 = acc[ai][bj][m][1];
#pragma unroll
                    for (int e = 0; e < 4; ++e) { v0[e] = sigmoidf_(v0[e]); v1[e] = sigmoidf_(v1[e]); }
                    st8(G + (size_t)row * 2048 + goff + colw + bj * 128, v0, v1); } }
    }
};
template <bool ADD> struct EpiMix {
    static constexpr bool PERM = true, AFTER_DRAIN = false;
    bf16_t* MIXIN; const bf16_t* G; int goff;
    __device__ __forceinline__ void operator()(AccRef acc, const Unit& u, int wr, int wc, int fr_, int fq_) const { run<false>(acc, u, wr, wc, fr_, fq_); }
    template <bool MINI> __device__ __forceinline__ void run(AccRef acc, const Unit& u, int wr, int wc, int fr_, int fq_) const {
        const int ln_ = fresh_tid(0), fr = ln_ & 15, fq = ln_ >> 4; (void)fr_; (void)fq_;
        const int row0 = u.pm * 256 + wr * 64 + fr, colw = u.pn * 256 + wc * 32 + 8 * fq;
#pragma unroll
        for (int ai = 0; ai < (MINI ? 1 : 2); ++ai)
#pragma unroll
            for (int m = 0; m < (MINI ? 1 : 4); ++m) { const int row = row0 + ai * 128 + m * 16;
#pragma unroll
                for (int bj = 0; bj < 2; ++bj) { const int col = colw + bj * 128; f32x4 g0, g1; ld8(G + (size_t)row * 2048 + goff + col, g0, g1);
                    f32x4 v0 = acc[ai][bj][m][0] * g0, v1 = acc[ai][bj][m][1] * g1;
                    if (ADD) { f32x4 p0, p1; ld8(MIXIN + (size_t)row * 1024 + col, p0, p1); v0 = v0 + p0; v1 = v1 + p1; }
                    st8(MIXIN + (size_t)row * 1024 + col, v0, v1); } }
    }
};
struct EpiSwiglu {
    static constexpr bool PERM = true, AFTER_DRAIN = false;
    bf16_t* FF;
    __device__ __forceinline__ void operator()(AccRef acc, const Unit& u, int wr, int wc, int fr_, int fq_) const { run<false>(acc, u, wr, wc, fr_, fq_); }
    template <bool MINI> __device__ __forceinline__ void run(AccRef acc, const Unit& u, int wr, int wc, int fr_, int fq_) const {
        const int ln_ = fresh_tid(0), fr = ln_ & 15, fq = ln_ >> 4; (void)fr_; (void)fq_;
        const int row0 = u.pm * 256 + wr * 64 + fr, col = u.pn * 128 + wc * 32 + 8 * fq;
#pragma unroll
        for (int ai = 0; ai < (MINI ? 1 : 2); ++ai)
#pragma unroll
            for (int m = 0; m < (MINI ? 1 : 4); ++m) { const int row = row0 + ai * 128 + m * 16;
                f32x4 g0 = acc[ai][0][m][0], g1 = acc[ai][0][m][1]; const f32x4 u0 = acc[ai][1][m][0], u1 = acc[ai][1][m][1];
#pragma unroll
                for (int e = 0; e < 4; ++e) { g0[e] = g0[e] * sigmoidf_(g0[e]) * u0[e]; g1[e] = g1[e] * sigmoidf_(g1[e]) * u1[e]; }
                st8(FF + (size_t)row * DFF + col, g0, g1); }
    }
};

template <class Epi> __device__ __forceinline__ void mini_gemm(LAS unsigned char* lds, int wave_, const bf16_t* __restrict__ A, const bf16_t* __restrict__ Bt, int N, int K, const Epi& E) {
    const int nunits = (N / 256) * 4, mu = launder_s((int)gridDim.x - 1 - (int)blockIdx.x);
    if (mu >= nunits) return;
    const int pn = mu >> 2, wc = mu & 3, lane = fresh_tid(0), fr = lane & 15, fq = lane >> 4;
    const int wave = launder_s(wave_); const bool w0 = wave == 0;
    f32x4 acc[2][2][4][2];
#pragma unroll
    for (int bj = 0; bj < 2; ++bj)
#pragma unroll
        for (int n = 0; n < 2; ++n) acc[0][bj][0][n] = (f32x4){0.f, 0.f, 0.f, 0.f};
    const bf16_t* ap = A + (size_t)(M0 + fr) * K + 8 * fq;
    const bf16_t* bp = Bt + (size_t)(256 * pn + 32 * wc + 8 * (fr >> 2) + (fr & 3)) * K + 8 * fq;
    for (int kb0 = 32 * wave; kb0 < K; kb0 += 1024) {
        bf16x8 a[4], b[4][4];
#pragma unroll
        for (int t = 0; t < 4; ++t) { const int k0 = kb0 + 256 * t;
            if (k0 < K) { a[t] = *(const bf16x8*)(ap + k0);
#pragma unroll
                for (int q = 0; q < 4; ++q) b[t][q] = *(const bf16x8*)(bp + (size_t)(128 * (q >> 1) + 4 * (q & 1)) * K + k0); } }
#pragma unroll
        for (int t = 0; t < 4; ++t) { const int k0 = kb0 + 256 * t;
            if (k0 < K) {
#pragma unroll
                for (int q = 0; q < 4; ++q) acc[0][q >> 1][0][q & 1] = __builtin_amdgcn_mfma_f32_16x16x32_bf16(b[t][q], a[t], acc[0][q >> 1][0][q & 1], 0, 0, 0); } }
    }
    LAS f32x4* part = (LAS f32x4*)lds;
#pragma unroll
    for (int bj = 0; bj < 2; ++bj)
#pragma unroll
        for (int n = 0; n < 2; ++n) part[(wave * 4 + bj * 2 + n) * 64 + lane] = acc[0][bj][0][n];
    __syncthreads();
    if (w0) {
#pragma unroll
        for (int bj = 0; bj < 2; ++bj)
#pragma unroll
            for (int n = 0; n < 2; ++n) { f32x4 t = part[(bj * 2 + n) * 64 + lane];
#pragma unroll
                for (int w = 1; w < 8; ++w) t = t + part[(w * 4 + bj * 2 + n) * 64 + lane];
                acc[0][bj][0][n] = t; }
    }
    __syncthreads();
    if (w0) { const Unit u{M0 / 256, pn}; E.template run<true>(acc, u, 0, wc, fr, fq); }
}

struct PairOrder {
    pg8::StaticOrder S; int pm_off;
    __device__ bool next(int i, Unit& u) const { if (!S.next(i >> 1, u)) return false; if (i & 1) { u.pm += pm_off; u.pn += 4; } return true; }
    __device__ __forceinline__ void a_ready(const Unit&) const {}
    __device__ __forceinline__ void done(const Unit&) const {}
};
constexpr int AO_PM_OFF = (int)((WS_AOB - WS_AOA) / (256 * 512 * 2));
static_assert((WS_AOB - WS_AOA) % (256 * 512 * 2) == 0 && AO_PM_OFF >= 129 && WO_ODIFF - WO_OMLA == 1024 * 512 * 2, "the paired branch projections address AOB / W_o_diff as row tiles behind AOA / W_o_mla");
struct EpiMixPair {
    static constexpr bool PERM = true, AFTER_DRAIN = false;
    bf16_t* MIXIN; const bf16_t* G;
    __device__ __forceinline__ void operator()(AccRef acc, const Unit& u, int wr, int wc, int fr_, int fq_) const {
        const int ln_ = fresh_tid(0), fr = ln_ & 15, fq = ln_ >> 4; (void)fr_; (void)fq_;
        const bool second = u.pn >= 4; const int pm = second ? u.pm - AO_PM_OFF : u.pm, pn = second ? u.pn - 4 : u.pn, goff = second ? 1024 : 0;
        const int row0 = pm * 256 + wr * 64 + fr, colw = pn * 256 + wc * 32 + 8 * fq;
#pragma unroll
        for (int ai = 0; ai < 2; ++ai)
#pragma unroll
            for (int m = 0; m < 4; ++m) { const int row = row0 + ai * 128 + m * 16;
#pragma unroll
                for (int bj = 0; bj < 2; ++bj) { const int col = colw + bj * 128; f32x4 g0, g1; ld8(G + (size_t)row * 2048 + goff + col, g0, g1);
                    f32x4 v0 = acc[ai][bj][m][0] * g0, v1 = acc[ai][bj][m][1] * g1;
                    if (second) { f32x4 p0, p1; ld8(MIXIN + (size_t)row * 1024 + col, p0, p1); v0 = v0 + p0; v1 = v1 + p1; }
                    st8(MIXIN + (size_t)row * 1024 + col, v0, v1); } }
    }
};
template <class Epi> __device__ __forceinline__ void run_gemm_pair(LAS unsigned char* lds, int wave, const bf16_t* A, const bf16_t* Bt, int K, const Epi& E, int pm_off) {
    pg8::Gemm g{A, Bt, M0, 1024, K}; PairOrder S; S.S.init(M0, 1024, launder_s((int)gridDim.x), launder_s((int)blockIdx.x)); S.pm_off = pm_off;
#ifndef NO_GEMM
    pg8::gemm_phase<Epi, PairOrder, true, true>(lds, g, S, E, wave);
#endif
}
#ifndef ONLY_GEMM
#define ONLY_GEMM -1
#endif
#ifndef PROBE_GEMM_MASK
#define PROBE_GEMM_MASK 0
#endif
#ifndef PROBE_GEMM_REP
#define PROBE_GEMM_REP 1
#endif
template <int ID, class Epi> __device__ __forceinline__ void run_gemm1(LAS unsigned char* lds, int wave, int gwave, const bf16_t* A, const bf16_t* Bt, int N, int K, const Epi& E, int Mrows) {
    if (Mrows == MP) mini_gemm(lds, wave, A, Bt, N, K, E);
    pg8::Gemm g{A, Bt, M0, N, K}; pg8::StaticOrder S; S.init(M0, N, launder_s((int)gridDim.x), launder_s((int)blockIdx.x));
#ifndef NO_GEMM
    if constexpr (ONLY_GEMM < 0 || ONLY_GEMM == ID) pg8::gemm_phase<Epi, pg8::StaticOrder, true, true>(lds, g, S, E, wave);
#endif
}
template <int ID, class Epi> __device__ __forceinline__ void run_gemm(LAS unsigned char* lds, int wave, int gwave, const bf16_t* A, const bf16_t* Bt, int N, int K, const Epi& E, int Mrows = MP) {
    for (int r = 0; r < ((PROBE_GEMM_MASK >> ID) & 1 ? PROBE_GEMM_REP : 1); ++r) run_gemm1<ID>(lds, wave, gwave, A, Bt, N, K, E, Mrows);
}

namespace att {
__device__ __forceinline__ float pair_sum_(float v, int lane) { return v + shx(v, 32, lane); }
typedef float f32x16 __attribute__((ext_vector_type(16)));
typedef short s16x4 __attribute__((ext_vector_type(4)));
typedef short v4i16_t __attribute__((ext_vector_type(4)));
typedef LAS const char* lds_cptr;
typedef LAS char* lds_ptr;
#define MFMA32(a, b, c) __builtin_amdgcn_mfma_f32_32x32x16_bf16((a), (b), (c), 0, 0, 0)
__device__ __forceinline__ int crow(int r, int hi) { return (r & 3) + 8 * (r >> 2) + 4 * hi; }
__device__ __forceinline__ s16x4 vtr(lds_cptr p) { return __builtin_bit_cast(s16x4, __builtin_amdgcn_ds_read_tr16_b64_v4i16((LAS v4i16_t*)p)); }
__device__ __forceinline__ bf16x8 pack8(const f32x16& p, int s) {
    u32x4 w; w.x = cvt_pk_bf16(p[8 * s], p[8 * s + 1]); w.y = cvt_pk_bf16(p[8 * s + 2], p[8 * s + 3]); w.z = cvt_pk_bf16(p[8 * s + 4], p[8 * s + 5]); w.w = cvt_pk_bf16(p[8 * s + 6], p[8 * s + 7]);
    return __builtin_bit_cast(bf16x8, w); }

template <int DK, int DV> struct Geo {
    static constexpr int NPK = DK / 8, NPV = DV / 8, KPS = 1024, VPS = 1088, KBYTES = NPK * KPS, VBYTES = NPV * VPS, NSLOT = 3;
};
template <int DK, int DV>
__device__ __forceinline__ void qk_tile(lds_cptr Kb, const bf16x8 (&qf)[DK / 16], int r32, int hi, f32x16& p0, f32x16& p1) {
    typedef Geo<DK, DV> G;
    f32x16 z;
#pragma unroll
    for (int i = 0; i < 16; ++i) z[i] = 0.f;
#pragma unroll
    for (int ds = 0; ds < DK / 16; ++ds) {
        const bf16x8 a0 = *(const LAS bf16x8*)(Kb + (2 * ds + hi) * G::KPS + r32 * 16);
        const bf16x8 a1 = *(const LAS bf16x8*)(Kb + (2 * ds + hi) * G::KPS + (32 + r32) * 16);
        if (ds == 0) { p0 = MFMA32(a0, qf[0], z); p1 = MFMA32(a1, qf[0], z); } else { p0 = MFMA32(a0, qf[ds], p0); p1 = MFMA32(a1, qf[ds], p1); }
    }
}
template <int DV, bool NEGM>
__device__ __forceinline__ void max_rescale(f32x16& p0, f32x16& p1, float& m, float& l, f32x16 (&o)[DV / 32], f32x16& negm, int lane, bool first) {
    float ra = fmaxf(fmaxf(p0[0], p0[1]), p1[0]), rb = fmaxf(fmaxf(p0[2], p0[3]), p1[1]); ra = fmaxf(fmaxf(ra, p1[2]), p1[3]);
#pragma unroll
    for (int i = 4; i < 16; i += 4) { ra = fmaxf(fmaxf(ra, p0[i]), p0[i + 1]); rb = fmaxf(fmaxf(rb, p0[i + 2]), p0[i + 3]); ra = fmaxf(fmaxf(ra, p1[i]), p1[i + 1]); rb = fmaxf(fmaxf(rb, p1[i + 2]), p1[i + 3]); }
    float rm = fmaxf(ra, rb);
    rm = fmaxf(rm, shx(rm, 32, lane));
    if (NEGM) {
        if (first || __builtin_amdgcn_ballot_w64(rm > 8.0f) != 0ull) {
            const float dl = first ? rm : fmaxf(rm, 0.f), alpha = first ? 1.0f : __builtin_amdgcn_exp2f(-dl); m += dl; l *= alpha;
#pragma unroll
            for (int i = 0; i < 16; ++i) { p0[i] -= dl; p1[i] -= dl; negm[i] = -m; }
#pragma unroll
            for (int d0 = 0; d0 < DV / 32; ++d0)
#pragma unroll
                for (int i = 0; i < 16; ++i) o[d0][i] *= alpha;
        }
    } else {
        if (__builtin_amdgcn_ballot_w64(rm > m + 8.0f) != 0ull) {
            const float mn = fmaxf(m, rm), alpha = __builtin_amdgcn_exp2f(m - mn); m = mn; l *= alpha;
#pragma unroll
            for (int d0 = 0; d0 < DV / 32; ++d0)
#pragma unroll
                for (int i = 0; i < 16; ++i) o[d0][i] *= alpha;
        }
    }
}
template <int DK, int DV, bool NEXT, bool NEGM>
__device__ __forceinline__ void fused_step(lds_cptr Kn, lds_cptr Vc, const bf16x8 (&qf)[DK / 16], bf16x8 ka0, bf16x8 ka1, const f32x16& cinit, f32x16& c0, f32x16& c1, f32x16& n0, f32x16& n1, float m, float& l, f32x16 (&o)[DV / 32],
                                           int r32, int hi, int q4, int p4, int blk) {
    typedef Geo<DK, DV> G;
    constexpr int NDS = DK / 16, ND0 = DV / 32;
    const lds_cptr kp = Kn + hi * G::KPS + r32 * 16;
    const lds_cptr vp = Vc + (2 * blk + (p4 >> 1)) * G::VPS + (4 * hi + q4) * 16 + 8 * (p4 & 1);
    bf16x8 ka[2][2]; ka[0][0] = ka0; ka[0][1] = ka1;
    s16x4 vlo[2][ND0], vhi[2][ND0];
#pragma unroll
    for (int ds = 0; ds < NDS; ++ds) {
        if (NEXT && ds + 1 < NDS) { ka[(ds + 1) & 1][0] = *(const LAS bf16x8*)(kp + (ds + 1) * 2 * G::KPS); ka[(ds + 1) & 1][1] = *(const LAS bf16x8*)(kp + (ds + 1) * 2 * G::KPS + 512); }
        if (ds == NDS - 1) {
#pragma unroll
            for (int d0 = 0; d0 < ND0; ++d0) { vlo[0][d0] = vtr(vp + d0 * 4 * G::VPS); vhi[0][d0] = vtr(vp + d0 * 4 * G::VPS + 128); }
        }
        if (NEXT) { if (ds == 0) { n0 = MFMA32(ka[0][0], qf[0], cinit); n1 = MFMA32(ka[0][1], qf[0], cinit); } else { n0 = MFMA32(ka[ds & 1][0], qf[ds], n0); n1 = MFMA32(ka[ds & 1][1], qf[ds], n1); } }
#pragma unroll
        for (int e = (ds * 32) / NDS; e < ((ds + 1) * 32) / NDS; ++e) { if (e < 16) c0[e] = __builtin_amdgcn_exp2f(NEGM ? c0[e] : c0[e] - m); else c1[e - 16] = __builtin_amdgcn_exp2f(NEGM ? c1[e - 16] : c1[e - 16] - m); }
        __builtin_amdgcn_sched_barrier(0);
    }
    float ls = 0.f;
#pragma unroll
    for (int c = 0; c < 4; ++c) {
        if (c + 1 < 4) {
#pragma unroll
            for (int d0 = 0; d0 < ND0; ++d0) { vlo[(c + 1) & 1][d0] = vtr(vp + d0 * 4 * G::VPS + (c + 1) * 256); vhi[(c + 1) & 1][d0] = vtr(vp + d0 * 4 * G::VPS + (c + 1) * 256 + 128); }
        }
        const f32x16& cc = (c >> 1) == 0 ? c0 : c1; const int s = c & 1;
        const bf16x8 pk = pack8(cc, s);
        ls += ((cc[8 * s] + cc[8 * s + 1]) + (cc[8 * s + 2] + cc[8 * s + 3])) + ((cc[8 * s + 4] + cc[8 * s + 5]) + (cc[8 * s + 6] + cc[8 * s + 7]));
#pragma unroll
        for (int d0 = 0; d0 < ND0; ++d0) {
            const bf16x8 vf = __builtin_shufflevector(vlo[c & 1][d0], vhi[c & 1][d0], 0, 1, 2, 3, 4, 5, 6, 7);
            o[d0] = MFMA32(vf, pk, o[d0]);
        }
        __builtin_amdgcn_sched_barrier(0);
    }
    l += ls;
}
template <int DK, int DV>
__device__ __forceinline__ void attn_pass(lds_ptr lds, int wave, const bf16_t* Q, int qpitch, int qrow, const bf16_t* __restrict__ K, int kpitch, const bf16_t* __restrict__ V, int vpitch,
                                          int xrow0, int ntiles, int qlim_meta, int qs, int wave_last_s, f32x16 (&o)[DV / 32], float& linv) {
    typedef Geo<DK, DV> G;
    const int tid = fresh_tid(wave), lane = tid & 63, r32 = lane & 31, hi = lane >> 5;
    bf16x8 qf[DK / 16];
#pragma unroll
    for (int ds = 0; ds < DK / 16; ++ds) qf[ds] = *(const bf16x8*)(Q + (size_t)qrow * qpitch + 16 * ds + 8 * hi);
    constexpr bool NEGM = (DK == 96);
    float m = NEGM ? 0.f : -1e30f, l = 0.f;
    f32x16 negm;
#pragma unroll
    for (int i = 0; i < 16; ++i) negm[i] = 0.f;
#pragma unroll
    for (int d0 = 0; d0 < DV / 32; ++d0)
#pragma unroll
        for (int i = 0; i < 16; ++i) o[d0][i] = 0.f;
    const lds_ptr KB0 = lds, VB0 = lds + G::NSLOT * G::KBYTES;
    const int wv = launder_s(wave);
    constexpr int NKW = (G::NPK + 7) / 8, NVW = (G::NPV + 7) / 8;
    const int nkw = (wv + 8 * (NKW - 1) < G::NPK) ? NKW : NKW - 1, nvw = (wv + 8 * (NVW - 1) < G::NPV) ? NVW : NVW - 1;
#define ATT_GROW(t) ((t) == 0 ? (size_t)M0 : (size_t)xrow0 + 64 * ((t) - 1))
#define ATT_DMAK(t, slot) do { const bf16_t* src_ = K + (ATT_GROW(t) + lane) * kpitch; \
        _Pragma("unroll") for (int i = 0; i < NKW; ++i) { const int c_ = wv + 8 * i; if (c_ < G::NPK) \
            __builtin_amdgcn_global_load_lds((const unsigned*)(src_ + c_ * 8), (LAS unsigned*)(KB0 + (slot) * G::KBYTES + c_ * G::KPS), 16, 0, 0); } } while (0)
#define ATT_DMAV(t, slot) do { const bf16_t* src_ = V + (ATT_GROW(t) + lane) * vpitch; \
        _Pragma("unroll") for (int i = 0; i < NVW; ++i) { const int c_ = wv + 8 * i; if (c_ < G::NPV) \
            __builtin_amdgcn_global_load_lds((const unsigned*)(src_ + c_ * 8), (LAS unsigned*)(VB0 + (slot) * G::VBYTES + c_ * G::VPS), 16, 0, 0); } } while (0)
#define ATT_WAIT_BAR(n) do { const int n_ = (n); \
        if (n_ == 0) asm volatile("s_waitcnt vmcnt(0) lgkmcnt(0)" ::: "memory"); else if (n_ == 1) asm volatile("s_waitcnt vmcnt(1) lgkmcnt(0)" ::: "memory"); \
        else if (n_ == 2) asm volatile("s_waitcnt vmcnt(2) lgkmcnt(0)" ::: "memory"); else if (n_ == 3) asm volatile("s_waitcnt vmcnt(3) lgkmcnt(0)" ::: "memory"); \
        else asm volatile("s_waitcnt vmcnt(4) lgkmcnt(0)" ::: "memory"); \
        __builtin_amdgcn_s_barrier(); asm volatile("" ::: "memory"); } while (0)
#define ATT_ACTIVE(j) ((j) == 0 || 64 * ((j) - 1) <= wave_last_s)
#define ATT_NEEDMASK(j) ((j) == 0 || 64 * ((j) - 1) + 63 > wave_last_s - 31)
    asm volatile("s_waitcnt vmcnt(0)" ::: "memory");
    ATT_DMAK(0, 0); ATT_DMAV(0, 0); if (ntiles > 1) ATT_DMAK(1, 1);
    int late = 0;
    if (ntiles > 1) { ATT_DMAV(1, 1); late += nvw; }
    if (ntiles > 2) { ATT_DMAK(2, 2); late += nkw; }
    ATT_WAIT_BAR(late);
    const int q4 = (lane & 15) >> 2, p4 = lane & 3, blk = (lane >> 4) & 1;
    f32x16 pA0, pA1, pB0, pB1;
    qk_tile<DK, DV>(KB0, qf, r32, hi, pA0, pA1);
    asm volatile("s_waitcnt lgkmcnt(0)" ::: "memory"); __builtin_amdgcn_s_barrier(); asm volatile("" ::: "memory");
    int sk1 = 1, sv0 = 0;
#define ATT_STEP(C0, C1, N0, N1, J) do { const int j_ = (J); int issued_ = 0; \
        if (j_ + 3 < ntiles) { ATT_DMAK(j_ + 3, sk1 == 0 ? 2 : sk1 - 1); issued_ += nkw; } \
        if (j_ + 2 < ntiles) { ATT_DMAV(j_ + 2, sv0 == 0 ? 2 : sv0 - 1); issued_ += nvw; } \
        const lds_cptr Kn_ = KB0 + sk1 * G::KBYTES; const lds_cptr Vc_ = VB0 + sv0 * G::VBYTES; \
        if (j_ < ntiles && ATT_ACTIVE(j_)) { \
              \
            const bf16x8 ka0_ = *(const LAS bf16x8*)(Kn_ + hi * G::KPS + r32 * 16), ka1_ = *(const LAS bf16x8*)(Kn_ + hi * G::KPS + (32 + r32) * 16); \
            if (ATT_NEEDMASK(j_)) { const int kvbase = (j_ == 0) ? 0 : 64 * (j_ - 1); const int qlim = (j_ == 0) ? qlim_meta : qs; \
                _Pragma("unroll") for (int i = 0; i < 16; ++i) { const int kv = kvbase + crow(i, hi); if (kv > qlim) C0[i] = -1e30f; if (kv + 32 > qlim) C1[i] = -1e30f; } } \
            max_rescale<DV, NEGM>(C0, C1, m, l, o, negm, lane, j_ == 0); \
            fused_step<DK, DV, true, NEGM>(Kn_, Vc_, qf, ka0_, ka1_, negm, C0, C1, N0, N1, m, l, o, r32, hi, q4, p4, blk); \
        } \
        sk1 = sk1 == 2 ? 0 : sk1 + 1; sv0 = sv0 == 2 ? 0 : sv0 + 1; \
        ATT_WAIT_BAR(issued_); } while (0)
    for (int j = 0; j < ntiles; j += 2) { ATT_STEP(pA0, pA1, pB0, pB1, j); ATT_STEP(pB0, pB1, pA0, pA1, j + 1); }
    asm volatile("s_waitcnt vmcnt(0)" ::: "memory");
#undef ATT_STEP
#undef ATT_GROW
#undef ATT_DMAK
#undef ATT_DMAV
#undef ATT_WAIT_BAR
#undef ATT_ACTIVE
#undef ATT_NEEDMASK
    l += shx(l, 32, lane);
    linv = 1.0f / l;
}

constexpr int LDS_NEED = 3 * ((Geo<64, 128>::KBYTES + Geo<64, 128>::VBYTES) > (Geo<96, 64>::KBYTES + Geo<96, 64>::VBYTES) ? (Geo<64, 128>::KBYTES + Geo<64, 128>::VBYTES) : (Geo<96, 64>::KBYTES + Geo<96, 64>::VBYTES));

struct Tensors { const bf16_t *QA, *KA, *VA, *QD, *KD, *VD; bf16_t *AOA, *AOB; const float* subln; float lam, lam_init; float* o1scr; };

__device__ __forceinline__ void mla_unit(lds_ptr lds, int wave, const Tensors& T, int b, int h, int qb, bool isx) {
    const int tid = fresh_tid(wave), lane = tid & 63, r32 = lane & 31, hi = lane >> 5, w = wave;
    int qrow, qs, qlim_meta, wave_last_s, ntiles, xrow0 = b * SEQ;
    if (isx) { qs = 256 * qb + 32 * w + r32; qrow = xrow0 + qs; qlim_meta = 15; wave_last_s = 256 * qb + 32 * w + 31; ntiles = 1 + 4 * (qb + 1); }
    else { qs = -1; qrow = M0 + 32 * w + r32; qlim_meta = r32 < 15 ? r32 : 15; wave_last_s = -1; ntiles = 1; if (w > 0) qlim_meta = 15; }
    f32x16 o[2]; float linv;
    attn_pass<96, 64>(lds, wave, T.QA + h * 96, 768, qrow, T.KA + h * 96, 768, T.VA + h * 64, 512, xrow0, ntiles, qlim_meta, qs, wave_last_s, o, linv);
    bf16_t* dst = T.AOA + (size_t)qrow * 512 + h * 64 + 4 * hi;
#pragma unroll
    for (int d0 = 0; d0 < 2; ++d0)
#pragma unroll
        for (int g = 0; g < 4; ++g) {
            uint2 wv; wv.x = cvt_pk_bf16(o[d0][4 * g] * linv, o[d0][4 * g + 1] * linv); wv.y = cvt_pk_bf16(o[d0][4 * g + 2] * linv, o[d0][4 * g + 3] * linv);
            *(uint2*)(dst + 32 * d0 + 8 * g) = wv; }
}
__device__ __forceinline__ void mla_unit64(lds_ptr lds, int wave, const Tensors& T, int b, int h, int qb8) {
    typedef Geo<96, 64> G; constexpr int NDS = 6, ND0 = 2;
    const int tid = fresh_tid(wave), lane = tid & 63, r32 = lane & 31, hi = lane >> 5;
    const int wv = launder_s(wave);
    const int xrow0 = b * SEQ, slab = 512 * qb8 + 64 * wv, sA = slab + r32, sB = sA + 32;
    const int ntiles = 1 + 8 * (qb8 + 1), last_active = 8 * qb8 + wv + 1;
    const bf16_t* Q = T.QA + h * 96; const bf16_t* __restrict__ K = T.KA + h * 96; const bf16_t* __restrict__ V = T.VA + h * 64;
    constexpr int kpitch = 768, vpitch = 512;
    bf16x8 qA[NDS], qB[NDS];
#pragma unroll
    for (int ds = 0; ds < NDS; ++ds) { qA[ds] = *(const bf16x8*)(Q + (size_t)(xrow0 + sA) * 768 + 16 * ds + 8 * hi); qB[ds] = *(const bf16x8*)(Q + (size_t)(xrow0 + sB) * 768 + 16 * ds + 8 * hi); }
    float mA = -1e30f, mB = -1e30f, lA = 0.f, lB = 0.f;
    f32x16 oA[ND0], oB[ND0], nz;
#pragma unroll
    for (int i = 0; i < 16; ++i) { oA[0][i] = 0.f; oA[1][i] = 0.f; oB[0][i] = 0.f; oB[1][i] = 0.f; nz[i] = 0.f; }
    const lds_ptr KB0 = lds, VB0 = lds + G::NSLOT * G::KBYTES;
    constexpr int NKW = (G::NPK + 7) / 8, NVW = (G::NPV + 7) / 8;
    const int nkw = (wv + 8 * (NKW - 1) < G::NPK) ? NKW : NKW - 1, nvw = (wv + 8 * (NVW - 1) < G::NPV) ? NVW : NVW - 1;
#define U64_GROW(t) ((t) == 0 ? (size_t)M0 : (size_t)xrow0 + 64 * ((t) - 1))
#define U64_DMAK(t, slot) do { const bf16_t* src_ = K + (U64_GROW(t) + lane) * kpitch; \
        _Pragma("unroll") for (int i = 0; i < NKW; ++i) { const int c_ = wv + 8 * i; if (c_ < G::NPK) \
            __builtin_amdgcn_global_load_lds((const unsigned*)(src_ + c_ * 8), (LAS unsigned*)(KB0 + (slot) * G::KBYTES + c_ * G::KPS), 16, 0, 0); } } while (0)
#define U64_DMAV(t, slot) do { const bf16_t* src_ = V + (U64_GROW(t) + lane) * vpitch; \
        _Pragma("unroll") for (int i = 0; i < NVW; ++i) { const int c_ = wv + 8 * i; if (c_ < G::NPV) \
            __builtin_amdgcn_global_load_lds((const unsigned*)(src_ + c_ * 8), (LAS unsigned*)(VB0 + (slot) * G::VBYTES + c_ * G::VPS), 16, 0, 0); } } while (0)
#define U64_WAIT_BAR(n) do { const int n_ = (n); \
        if (n_ == 0) asm volatile("s_waitcnt vmcnt(0) lgkmcnt(0)" ::: "memory"); else if (n_ == 1) asm volatile("s_waitcnt vmcnt(1) lgkmcnt(0)" ::: "memory"); \
        else if (n_ == 2) asm volatile("s_waitcnt vmcnt(2) lgkmcnt(0)" ::: "memory"); else if (n_ == 3) asm volatile("s_waitcnt vmcnt(3) lgkmcnt(0)" ::: "memory"); \
        else asm volatile("s_waitcnt vmcnt(4) lgkmcnt(0)" ::: "memory"); \
        __builtin_amdgcn_s_barrier(); asm volatile("" ::: "memory"); } while (0)
    asm volatile("s_waitcnt vmcnt(0)" ::: "memory");
    U64_DMAK(0, 0); U64_DMAV(0, 0);
    U64_DMAK(1, 1); U64_DMAV(1, 1);
    U64_WAIT_BAR(nkw + nvw);
    const int q4 = (lane & 15) >> 2, p4 = lane & 3, blk = (lane >> 4) & 1;
    int sk = 0;
    for (int j = 0; j < ntiles; ++j) {
        int issued = 0;
        if (j + 2 < ntiles) { const int s2 = sk == 0 ? 2 : sk - 1; U64_DMAK(j + 2, s2); U64_DMAV(j + 2, s2); issued = nkw + nvw; }
        if (j <= last_active) {
            const lds_cptr kp = KB0 + sk * G::KBYTES + hi * G::KPS + r32 * 16;
            const lds_cptr vp = VB0 + sk * G::VBYTES + (2 * blk + (p4 >> 1)) * G::VPS + (4 * hi + q4) * 16 + 8 * (p4 & 1);
            f32x16 a0, a1, b0, b1;
            bf16x8 ka[2][2]; ka[0][0] = *(const LAS bf16x8*)(kp); ka[0][1] = *(const LAS bf16x8*)(kp + 512);
#pragma unroll
            for (int ds = 0; ds < NDS; ++ds) {
                if (ds + 1 < NDS) { ka[(ds + 1) & 1][0] = *(const LAS bf16x8*)(kp + (ds + 1) * 2 * G::KPS); ka[(ds + 1) & 1][1] = *(const LAS bf16x8*)(kp + (ds + 1) * 2 * G::KPS + 512); }
                if (ds == 0) { a0 = MFMA32(ka[0][0], qA[0], nz); a1 = MFMA32(ka[0][1], qA[0], nz); b0 = MFMA32(ka[0][0], qB[0], nz); b1 = MFMA32(ka[0][1], qB[0], nz); }
                else { a0 = MFMA32(ka[ds & 1][0], qA[ds], a0); a1 = MFMA32(ka[ds & 1][1], qA[ds], a1); b0 = MFMA32(ka[ds & 1][0], qB[ds], b0); b1 = MFMA32(ka[ds & 1][1], qB[ds], b1); }
                __builtin_amdgcn_sched_barrier(0);
            }
            if (j == 0 || j == last_active) { const int kvbase = (j == 0) ? 0 : 64 * (j - 1); const int limA = (j == 0) ? 15 : sA, limB = (j == 0) ? 15 : sB;
#pragma unroll
                for (int i = 0; i < 16; ++i) { const int kv = kvbase + crow(i, hi);
                    if (kv > limA) a0[i] = -1e30f; if (kv + 32 > limA) a1[i] = -1e30f; if (kv > limB) b0[i] = -1e30f; if (kv + 32 > limB) b1[i] = -1e30f; } }
            max_rescale<64, false>(a0, a1, mA, lA, oA, nz, lane, false);
            max_rescale<64, false>(b0, b1, mB, lB, oB, nz, lane, false);
            s16x4 vlo[2][ND0], vhi[2][ND0];
#pragma unroll
            for (int d0 = 0; d0 < ND0; ++d0) { vlo[0][d0] = vtr(vp + d0 * 4 * G::VPS); vhi[0][d0] = vtr(vp + d0 * 4 * G::VPS + 128); }
#pragma unroll
            for (int i = 0; i < 16; ++i) { a0[i] = __builtin_amdgcn_exp2f(a0[i] - mA); a1[i] = __builtin_amdgcn_exp2f(a1[i] - mA); b0[i] = __builtin_amdgcn_exp2f(b0[i] - mB); b1[i] = __builtin_amdgcn_exp2f(b1[i] - mB); }
            __builtin_amdgcn_sched_barrier(0);
            float lsA = 0.f, lsB = 0.f;
#pragma unroll
            for (int c = 0; c < 4; ++c) {
                if (c + 1 < 4) {
#pragma unroll
                    for (int d0 = 0; d0 < ND0; ++d0) { vlo[(c + 1) & 1][d0] = vtr(vp + d0 * 4 * G::VPS + (c + 1) * 256); vhi[(c + 1) & 1][d0] = vtr(vp + d0 * 4 * G::VPS + (c + 1) * 256 + 128); }
                }
                const f32x16& ca = (c >> 1) == 0 ? a0 : a1; const f32x16& cb = (c >> 1) == 0 ? b0 : b1; const int s = c & 1;
                const bf16x8 pkA = pack8(ca, s), pkB = pack8(cb, s);
                lsA += ((ca[8 * s] + ca[8 * s + 1]) + (ca[8 * s + 2] + ca[8 * s + 3])) + ((ca[8 * s + 4] + ca[8 * s + 5]) + (ca[8 * s + 6] + ca[8 * s + 7]));
                lsB += ((cb[8 * s] + cb[8 * s + 1]) + (cb[8 * s + 2] + cb[8 * s + 3])) + ((cb[8 * s + 4] + cb[8 * s + 5]) + (cb[8 * s + 6] + cb[8 * s + 7]));
#pragma unroll
                for (int d0 = 0; d0 < ND0; ++d0) {
                    const bf16x8 vf = __builtin_shufflevector(vlo[c & 1][d0], vhi[c & 1][d0], 0, 1, 2, 3, 4, 5, 6, 7);
                    oA[d0] = MFMA32(vf, pkA, oA[d0]); oB[d0] = MFMA32(vf, pkB, oB[d0]);
                }
                __builtin_amdgcn_sched_barrier(0);
            }
            lA += lsA; lB += lsB;
        }
        sk = sk == 2 ? 0 : sk + 1;
        U64_WAIT_BAR(issued);
    }
    asm volatile("s_waitcnt vmcnt(0)" ::: "memory");
#undef U64_GROW
#undef U64_DMAK
#undef U64_DMAV
#undef U64_WAIT_BAR
    const float liA = 1.0f / pair_sum_(lA, lane), liB = 1.0f / pair_sum_(lB, lane);
    bf16_t* dA = T.AOA + (size_t)(xrow0 + sA) * 512 + h * 64 + 4 * hi; bf16_t* dB = T.AOA + (size_t)(xrow0 + sB) * 512 + h * 64 + 4 * hi;
#pragma unroll
    for (int d0 = 0; d0 < 2; ++d0)
#pragma unroll
        for (int g = 0; g < 4; ++g) {
            uint2 wa; wa.x = cvt_pk_bf16(oA[d0][4 * g] * liA, oA[d0][4 * g + 1] * liA); wa.y = cvt_pk_bf16(oA[d0][4 * g + 2] * liA, oA[d0][4 * g + 3] * liA);
            uint2 wb; wb.x = cvt_pk_bf16(oB[d0][4 * g] * liB, oB[d0][4 * g + 1] * liB); wb.y = cvt_pk_bf16(oB[d0][4 * g + 2] * liB, oB[d0][4 * g + 3] * liB);
            *(uint2*)(dA + 32 * d0 + 8 * g) = wa; *(uint2*)(dB + 32 * d0 + 8 * g) = wb; }
}
__device__ __forceinline__ void diff_unit(lds_ptr lds, int wave, const Tensors& T, int b, int h, int qb, bool isx) {
    const int tid = fresh_tid(wave), lane = tid & 63, r32 = lane & 31, hi = lane >> 5, w = wave;
    int qrow, qs, qlim_meta, wave_last_s, ntiles, xrow0 = b * SEQ;
    if (isx) { qs = 256 * qb + 32 * w + r32; qrow = xrow0 + qs; qlim_meta = 15; wave_last_s = 256 * qb + 32 * w + 31; ntiles = 1 + 4 * (qb + 1); }
    else { qs = -1; qrow = M0 + 32 * w + r32; qlim_meta = r32 < 15 ? r32 : 15; wave_last_s = -1; ntiles = 1; if (w > 0) qlim_meta = 15; }
    f32x16 o2[4]; float linv2;
    f32x4* sp = (f32x4*)(T.o1scr) + tid;
    {
        f32x16 o1[4]; float linv1;
        attn_pass<64, 128>(lds, wave, T.QD + (2 * h) * 64, 512, qrow, T.KD + (2 * h) * 64, 512, T.VD + h * 128, 512, xrow0, ntiles, qlim_meta, qs, wave_last_s, o1, linv1);
#pragma unroll
        for (int d0 = 0; d0 < 4; ++d0)
#pragma unroll
            for (int g = 0; g < 4; ++g) sp[(d0 * 4 + g) * 512] = (f32x4){o1[d0][4 * g] * linv1, o1[d0][4 * g + 1] * linv1, o1[d0][4 * g + 2] * linv1, o1[d0][4 * g + 3] * linv1};
    }
    attn_pass<64, 128>(lds, wave, T.QD + (2 * h + 1) * 64, 512, qrow, T.KD + (2 * h + 1) * 64, 512, T.VD + h * 128, 512, xrow0, ntiles, qlim_meta, qs, wave_last_s, o2, linv2);
    const float lam2 = T.lam * linv2; float ss = 0.f;
    f32x16 o1[4];
#pragma unroll
    for (int d0 = 0; d0 < 4; ++d0)
#pragma unroll
        for (int g = 0; g < 4; ++g) { const f32x4 t = sp[(d0 * 4 + g) * 512]; o1[d0][4 * g] = t[0]; o1[d0][4 * g + 1] = t[1]; o1[d0][4 * g + 2] = t[2]; o1[d0][4 * g + 3] = t[3]; }
#pragma unroll
    for (int d0 = 0; d0 < 4; ++d0)
#pragma unroll
        for (int i = 0; i < 16; ++i) { const float d = o1[d0][i] - lam2 * o2[d0][i]; o1[d0][i] = d; ss += d * d; }
    ss += shx(ss, 32, lane);
    const float rs = rsqrtf(ss * (1.0f / 128.0f) + EPS) * (1.0f - T.lam_init);
    bf16_t* dst = T.AOB + (size_t)qrow * 512 + h * 128 + 4 * hi;
#pragma unroll
    for (int d0 = 0; d0 < 4; ++d0)
#pragma unroll
        for (int g = 0; g < 4; ++g) { const f32x4 sg = *(const f32x4*)(T.subln + 32 * d0 + 8 * g + 4 * hi);
            uint2 wv; wv.x = cvt_pk_bf16(o1[d0][4 * g] * rs * sg[0], o1[d0][4 * g + 1] * rs * sg[1]); wv.y = cvt_pk_bf16(o1[d0][4 * g + 2] * rs * sg[2], o1[d0][4 * g + 3] * rs * sg[3]);
            *(uint2*)(dst + 32 * d0 + 8 * g) = wv; }
}
__device__ __forceinline__ void attn_phase(lds_ptr lds, int wave, const Tensors& T, int vcu_, int G_) {
    const int vcu = launder_s(vcu_), G = launder_s(G_);
    for (int v = vcu; v < 256; v += G) {
        { const int bh = v >> 3, s = v & 7;
#ifndef NO_DIFF
          diff_unit(lds, wave, T, bh >> 2, bh & 3, s, true); diff_unit(lds, wave, T, bh >> 2, bh & 3, 15 - s, true);
#endif
        }
        { const int bh = v >> 2, s = v & 3;
#ifndef NO_MLA
          mla_unit64(lds, wave, T, bh >> 3, bh & 7, s); mla_unit64(lds, wave, T, bh >> 3, bh & 7, 7 - s);
#endif
        }
#ifndef NO_MLA
        if (v < 8) mla_unit(lds, wave, T, 0, v, 0, false);
#endif
#ifndef NO_DIFF
        if (v >= 8 && v < 12) diff_unit(lds, wave, T, 0, v - 8, 0, false);
#endif
    }
}
}

#define XB_TMO      128
#define XB_XCNT(j)  (256  + 64 * (j))
#define XB_XSUB(j)  (1280 + 64 * (j))
#define XB_XGEN(j)  (2304 + 64 * (j))
#define XB_TOP      3328
#define XB_TOPGEN   3392
#define XCD_BAR_WORDS 3456
#define XB_SPIN_CAP (1u << 18)

__device__ __forceinline__ unsigned xb_ld(unsigned* p)              { return __hip_atomic_load(p, __ATOMIC_RELAXED, __HIP_MEMORY_SCOPE_AGENT); }
__device__ __forceinline__ unsigned xb_add(unsigned* p, unsigned v) { return __hip_atomic_fetch_add(p, v, __ATOMIC_RELAXED, __HIP_MEMORY_SCOPE_AGENT); }
__device__ __forceinline__ unsigned xb_xcc_id() { return (unsigned)__builtin_amdgcn_s_getreg((3 << 11) | 20) & 0xFu; }
#define XB_SPIN(cond, bar) do { unsigned _sp = 0; while (cond) { __builtin_amdgcn_s_sleep(1); \
    if ((++_sp & 255u) == 0u) { if (xb_ld(&(bar)[XB_TMO])) break; if (_sp > XB_SPIN_CAP) { atomicAdd(&(bar)[XB_TMO], 1u); break; } } } } while (0)

struct XcdBarrier { unsigned* bar; unsigned x; volatile LAS unsigned* st; };
__device__ __forceinline__ XcdBarrier xcd_barrier_post(unsigned* bar, volatile LAS unsigned* st, int tid) {
    XcdBarrier b; b.bar = bar; b.x = xb_xcc_id(); b.st = st;
    if (tid == 0) (void)xb_add(&bar[XB_XCNT(b.x)], 1u);
    return b;
}
__device__ __forceinline__ void xcd_barrier_complete(unsigned* bar, unsigned x, unsigned& nloc, unsigned& nx) {
    const unsigned G = gridDim.x * gridDim.y * gridDim.z;
    unsigned sum, cnt, mine, sp = 0u;
    for (;;) {
        sum = 0u; cnt = 0u; mine = 0u;
#pragma unroll
        for (unsigned j = 0; j < 16; ++j) { const unsigned c = xb_ld(&bar[XB_XCNT(j)]); sum += c; cnt += (c > 0u) ? 1u : 0u; mine = (j == x) ? c : mine; }
        if (sum == G) break;
        __builtin_amdgcn_s_sleep(1);
        if ((++sp & 255u) == 0u) { if (xb_ld(&bar[XB_TMO])) break; if (sp > XB_SPIN_CAP) { atomicAdd(&bar[XB_TMO], 1u); break; } }
    }
    nloc = mine > 0u ? mine : 1u; nx = cnt > 0u ? cnt : 1u;
}

__device__ __forceinline__ void xcd_barrier(const XcdBarrier& b, int tid) {
    asm volatile("s_waitcnt vmcnt(0)" ::: "memory");
    __syncthreads();
    if (tid == 0) {
        unsigned* bar = b.bar;
        __builtin_amdgcn_s_waitcnt(0);
        unsigned nloc = b.st[0], nx = b.st[1];
        if (nloc == 0u) { xcd_barrier_complete(bar, b.x, nloc, nx); b.st[0] = nloc; b.st[1] = nx; }
        const unsigned old = xb_add(&bar[XB_XSUB(b.x)], 1u);
        const unsigned gen = old / nloc;
        if (old + 1u == (gen + 1u) * nloc) {
            __builtin_amdgcn_fence(__ATOMIC_RELEASE, "agent");
            asm volatile("s_waitcnt vmcnt(0)" ::: "memory");
            const unsigned og = xb_add(&bar[XB_TOP], 1u);
            const unsigned tg = og / nx;
            if (og + 1u == (tg + 1u) * nx) xb_add(&bar[XB_TOPGEN], 1u);
            else XB_SPIN(xb_ld(&bar[XB_TOPGEN]) == tg, bar);
            __builtin_amdgcn_fence(__ATOMIC_ACQUIRE, "agent");
            xb_add(&bar[XB_XGEN(b.x)], 1u);
            asm volatile("s_waitcnt vmcnt(0)" ::: "memory");
        } else {
            XB_SPIN(xb_ld(&bar[XB_XGEN(b.x)]) == gen, bar);
            __builtin_amdgcn_fence(__ATOMIC_ACQUIRE, "agent");
            asm volatile("s_waitcnt vmcnt(0)" ::: "memory");
        }
    }
    __syncthreads();
}

enum { WK_ID = 0, WK_INA, WK_INB, WK_UQ, WK_UKV, WK_GU };
__device__ __forceinline__ int src_col(int kind, int n) {
    switch (kind) {
    case WK_INA: {
        if (n < 1024) { const int seg = n >> 9, g = (n & 511) >> 6, j = n & 63; const int t = j < 16 ? ((j & 1) ? 8 + (j >> 1) : (j >> 1)) : j; return (seg == 0 ? 672 : 1184) + 64 * g + t; }
        if (n < 1536) return 1696 + (n - 1024);
        if (n < 1792) return 384 + (n - 1536);
        if (n < 2176) return n - 1792;
        if (n < 2208) { const int j = n - 2176; return 640 + ((j & 1) ? 16 + (j >> 1) : (j >> 1)); }
        return -1; }
    case WK_INB: return 2208 + n;
    case WK_UQ: { const int hd = n / 96, j = n % 96; if (j < 64) return n; const int jj = j - 64; return hd * 96 + 64 + ((jj & 1) ? 16 + (jj >> 1) : (jj >> 1)); }
    case WK_UKV: { if (n < 512) return (n >> 6) * 128 + (n & 63); const int nn = n - 512; return (nn >> 6) * 128 + 64 + (nn & 63); }
    case WK_GU: { const int t = n >> 8, c = n & 255; return c < 128 ? 128 * t + c : DFF + 128 * t + (c - 128); }
    default: return n;
    }
}
__device__ __forceinline__ void transpose_item(const float* __restrict__ W, int K, int N, const float* __restrict__ gain, bf16_t* WT, int kind, LAS float* scr, int item, int lane) {
    const int kblk = K / 64, nb = item / kblk, kb = item % kblk, k0 = 64 * kb, n0 = 32 * nb;
    const int s0 = src_col(kind, n0), base = s0 & ~31;
    f32x4 v[8];
    const int c4 = lane & 7, kr = lane >> 3;
    if (s0 >= 0) {
#pragma unroll
        for (int i = 0; i < 8; ++i) v[i] = *(const f32x4*)(W + (size_t)(k0 + kr + 8 * i) * N + base + 4 * c4);
        if (gain) {
#pragma unroll
            for (int i = 0; i < 8; ++i) v[i] = v[i] * gain[k0 + kr + 8 * i];
        }
    } else {
#pragma unroll
        for (int i = 0; i < 8; ++i) v[i] = (f32x4){0.f, 0.f, 0.f, 0.f};
    }
#pragma unroll
    for (int i = 0; i < 8; ++i) { LAS float* d = scr + (kr + 8 * i) * 33 + 4 * c4; d[0] = v[i][0]; d[1] = v[i][1]; d[2] = v[i][2]; d[3] = v[i][3]; }
    asm volatile("s_waitcnt lgkmcnt(0)" ::: "memory");
    const int c = lane & 7;
#pragma unroll
    for (int j = 0; j < 4; ++j) { const int n = (lane >> 3) + 8 * j; const int sc = s0 >= 0 ? src_col(kind, n0 + n) - base : n; const LAS float* s = scr + (8 * c) * 33 + sc;
        u32x4 o; o.x = pk2(s[0 * 33], s[1 * 33]); o.y = pk2(s[2 * 33], s[3 * 33]); o.z = pk2(s[4 * 33], s[5 * 33]); o.w = pk2(s[6 * 33], s[7 * 33]);
        *(u32x4*)(WT + (size_t)(n0 + n) * K + k0 + 8 * c) = o; }
    asm volatile("s_waitcnt lgkmcnt(0)" ::: "memory");
}
struct WDesc { int in_idx, K, N, Np, kind, gain_idx; size_t off; };
__device__ __forceinline__ WDesc wdesc(int i) {
    switch (i) {
    case 0: return WDesc{I_WIN, 1024, 4256, 2304, WK_INA, -1, WO_INA};
    case 1: return WDesc{I_WIN, 1024, 4256, 2048, WK_INB, -1, WO_INB};
    case 2: return WDesc{I_WUQ, 384, 768, 768, WK_UQ, I_QNORM, WO_UQ};
    case 3: return WDesc{I_WUKV, 256, 1024, 1024, WK_UKV, I_KVNORM, WO_UKV};
    case 4: return WDesc{I_WOMLA, 512, 1024, 1024, WK_ID, -1, WO_OMLA};
    case 5: return WDesc{I_WODIFF, 512, 1024, 1024, WK_ID, -1, WO_ODIFF};
    case 6: return WDesc{I_WOUT, 1024, 1024, 1024, WK_ID, -1, WO_OUT};
    case 7: return WDesc{I_WGU, 1024, 5632, 5632, WK_GU, -1, WO_GU};
    default: return WDesc{I_WDOWN, 2816, 1024, 1024, WK_ID, -1, WO_DOWN};
    }
}
__device__ __forceinline__ void wave_sum4(float (&s)[4], int lane) {
#pragma unroll
    for (int o = 1; o < 64; o <<= 1) {
        float t[4];
#pragma unroll
        for (int r = 0; r < 4; ++r) t[r] = shx(s[r], o, lane);
#pragma unroll
        for (int r = 0; r < 4; ++r) s[r] += t[r];
    }
}
__device__ __forceinline__ void row_pass(int gw_, int ngw_, int wave_, int nrows, const float* rin_x, const float* rin_m, const bf16_t* mix, const float* gpost, const bf16_t* mix2, const float* gpost2, float* rout_x, float* rout_m, const float* gnext, bf16_t* XN) {
    const int lane = fresh_tid(wave_) & 63; const int gw = launder_s(gw_), ngw = launder_s(ngw_);
    static_assert(M0 % 4 == 0 && MVALID % 4 == 0 && MP % 4 == 0, "row groups of 4 never straddle a buffer boundary");
    for (int g = gw; g < nrows / 4; g += ngw) {
        const int row0 = 4 * g;
        if (row0 >= MVALID) { if (XN) {
#pragma unroll
                for (int r = 0; r < 4; ++r) { unsigned long long* o8 = (unsigned long long*)(XN + (size_t)(row0 + r) * DM) + lane;
#pragma unroll
                    for (int j = 0; j < 4; ++j) o8[64 * j] = 0ull; } } continue; }
        const float* rp = row0 < M0 ? rin_x + (size_t)row0 * DM : rin_m + (size_t)(row0 - M0) * DM;
        f32x4 v[4][4];
#pragma unroll
        for (int r = 0; r < 4; ++r)
#pragma unroll
            for (int j = 0; j < 4; ++j) v[r][j] = __builtin_nontemporal_load((const f32x4*)(rp + (size_t)r * DM) + lane + 64 * j);
        if (mix) {
            uint2 mw[4][4];
#pragma unroll
            for (int r = 0; r < 4; ++r)
#pragma unroll
                for (int j = 0; j < 4; ++j) { typedef unsigned u32x2_ __attribute__((ext_vector_type(2))); const u32x2_ t_ = __builtin_nontemporal_load((const u32x2_*)(mix + (size_t)(row0 + r) * DM) + lane + 64 * j); mw[r][j].x = t_.x; mw[r][j].y = t_.y; }
            f32x4 gp[4];
#pragma unroll
            for (int j = 0; j < 4; ++j) gp[j] = ((const f32x4*)gpost)[lane + 64 * j];
            float s[4];
#pragma unroll
            for (int r = 0; r < 4; ++r) { s[r] = 0.f;
#pragma unroll
                for (int j = 0; j < 4; ++j) { const f32x4 m4 = (f32x4){bflo(mw[r][j].x), bfhi(mw[r][j].x), bflo(mw[r][j].y), bfhi(mw[r][j].y)}; s[r] += sumsq4(m4); } }
            wave_sum4(s, lane);
#pragma unroll
            for (int r = 0; r < 4; ++r) { const float rs = rsqrtf(s[r] * (1.0f / DM) + EPS);
#pragma unroll
                for (int j = 0; j < 4; ++j) { const f32x4 m4 = (f32x4){bflo(mw[r][j].x), bfhi(mw[r][j].x), bflo(mw[r][j].y), bfhi(mw[r][j].y)}; v[r][j] = v[r][j] + m4 * rs * gp[j]; } }
        }
        if (mix2) {
            uint2 mw[4][4];
#pragma unroll
            for (int r = 0; r < 4; ++r)
#pragma unroll
                for (int j = 0; j < 4; ++j) { typedef unsigned u32x2_ __attribute__((ext_vector_type(2))); const u32x2_ t_ = __builtin_nontemporal_load((const u32x2_*)(mix2 + (size_t)(row0 + r) * DM) + lane + 64 * j); mw[r][j].x = t_.x; mw[r][j].y = t_.y; }
            f32x4 gp[4];
#pragma unroll
            for (int j = 0; j < 4; ++j) gp[j] = ((const f32x4*)gpost2)[lane + 64 * j];
            float s[4];
#pragma unroll
            for (int r = 0; r < 4; ++r) { s[r] = 0.f;
#pragma unroll
                for (int j = 0; j < 4; ++j) { const f32x4 m4 = (f32x4){bflo(mw[r][j].x), bfhi(mw[r][j].x), bflo(mw[r][j].y), bfhi(mw[r][j].y)}; s[r] += sumsq4(m4); } }
            wave_sum4(s, lane);
#pragma unroll
            for (int r = 0; r < 4; ++r) { const float rs = rsqrtf(s[r] * (1.0f / DM) + EPS);
#pragma unroll
                for (int j = 0; j < 4; ++j) { const f32x4 m4 = (f32x4){bflo(mw[r][j].x), bfhi(mw[r][j].x), bflo(mw[r][j].y), bfhi(mw[r][j].y)}; v[r][j] = v[r][j] + m4 * rs * gp[j]; } }
        }
        if (rout_x) { float* op = row0 < M0 ? rout_x + (size_t)row0 * DM : rout_m + (size_t)(row0 - M0) * DM;
#pragma unroll
            for (int r = 0; r < 4; ++r)
#pragma unroll
                for (int j = 0; j < 4; ++j) ((f32x4*)(op + (size_t)r * DM))[lane + 64 * j] = v[r][j]; }
        if (XN) { float s[4];
#pragma unroll
            for (int r = 0; r < 4; ++r) { s[r] = 0.f;
#pragma unroll
                for (int j = 0; j < 4; ++j) s[r] += sumsq4(v[r][j]); }
            wave_sum4(s, lane);
            f32x4 gn[4];
#pragma unroll
            for (int j = 0; j < 4; ++j) gn[j] = ((const f32x4*)gnext)[lane + 64 * j];
#pragma unroll
            for (int r = 0; r < 4; ++r) { const float rs = rsqrtf(s[r] * (1.0f / DM) + EPS); unsigned long long* o8 = (unsigned long long*)(XN + (size_t)(row0 + r) * DM) + lane;
#pragma unroll
                for (int j = 0; j < 4; ++j) { const f32x4 y = v[r][j] * rs * gn[j];
                    o8[64 * j] = (unsigned long long)cvt_pk_bf16(y[0], y[1]) | ((unsigned long long)cvt_pk_bf16(y[2], y[3]) << 32); } } }
    }
}

constexpr int LDS_BYTES = 131072 + 1024;
static_assert(att::LDS_NEED <= 131072, "attention LDS");
__global__ void __launch_bounds__(512, 2) fwd_megakernel(Params p) {
    extern __shared__ __attribute__((aligned(16))) unsigned char lds_raw[];
    LAS unsigned char* lds = (LAS unsigned char*)lds_raw;
    cg::grid_group grid = cg::this_grid();
    const int wave = __builtin_amdgcn_readfirstlane((int)threadIdx.x >> 6);
    const int G = gridDim.x, bx = blockIdx.x, vcu = (G % 8 == 0) ? (bx % 8) * (G / 8) + bx / 8 : bx;
    const int gw = vcu * 8 + wave, ngw = G * 8;
    { const int t0 = fresh_tid(wave); if (t0 < 64) ((LAS unsigned*)(lds + 131072))[t0] = 0u; __syncthreads(); }
    const XcdBarrier xbar = xcd_barrier_post((unsigned*)(p.ws + WS_BAR), (volatile LAS unsigned*)(lds + 131072 + 32), fresh_tid(wave));
#define GRID_BAR() xcd_barrier(xbar, fresh_tid(wave))
#define WSP() ({ unsigned char* w__ = p.ws; asm volatile("" : "+s"(w__)); w__; })
#define B16(w, off) ((bf16_t*)((w) + (off)))
    {
        unsigned char* ws = WSP();
        float* lamp = (float*)(ws + WS_LAM); float* rope = (float*)(ws + WS_ROPE);
        LAS float* scr = (LAS float*)(lds + wave * 16384);
        const int tid = fresh_tid(wave), lane = tid & 63;
        for (int L = 0; L < NLAYER; ++L)
            for (int wi = 0; wi < 9; ++wi) {
                const WDesc d = wdesc(wi);
                const float* W = p.in[d.in_idx] + (size_t)L * d.K * d.N;
                const float* gain = d.gain_idx >= 0 ? p.in[d.gain_idx] + (size_t)L * d.K : nullptr;
                bf16_t* WT = (bf16_t*)(ws + WS_W + L * WS_WSTRIDE + d.off);
                const int nitems = (d.Np / 32) * (d.K / 64);
                for (int it = gw; it < nitems; it += ngw) transpose_item(W, d.K, d.N, gain, WT, d.kind, scr, it, lane);
            }
        for (int i = bx * 512 + tid; i < NPOS * 24; i += G * 512) { const int pos = i / 24, f = i % 24; const double rev = (double)pos * p.invrev[f]; const float fr = (float)(rev - floor(rev));
            rope[2 * i] = __builtin_amdgcn_cosf(fr); rope[2 * i + 1] = __builtin_amdgcn_sinf(fr); }
        if (launder_s(bx) == 0 && launder_s(wave) == 0) {
            for (int L = 0; L < NLAYER; ++L) { const float* lp = p.in[I_LAMBDA] + L * 256;
                const float a = wave_sum(lp[lane] * lp[64 + lane], lane), b = wave_sum(lp[128 + lane] * lp[192 + lane], lane);
                const float lam_init = L == 0 ? 0.2f : 0.35550906759096924f;
                if (lane == 0) lamp[L] = expf(a) - expf(b) + lam_init; }
        }
        row_pass(gw, ngw, wave, MP, p.in[I_X], p.in[I_META], nullptr, nullptr, nullptr, nullptr, nullptr, nullptr, p.in[I_NMIXPRE], B16(ws, WS_XN));
    }
    grid.sync();

    for (int L = 0; L < NLAYER; ++L) {
        const size_t wlo = WS_W + L * WS_WSTRIDE;
        const size_t sqo = WS_SSQQ, skvo = WS_SSQKV;
        const int Mpost = (L + 1 < NLAYER) ? MP : M0;
        { unsigned char* ws = WSP();
          EpiInA E{B16(ws, WS_QD), B16(ws, WS_KD), B16(ws, WS_VD), B16(ws, WS_KVL), B16(ws, WS_QL), B16(ws, WS_KA), (float*)(ws + sqo), (float*)(ws + skvo), (const float*)(ws + WS_ROPE)};
          run_gemm<0>(lds, wave, gw, B16(ws, WS_XN), B16(ws, wlo + WO_INA), 2304, 1024, E); }
        GRID_BAR();
        { unsigned char* ws = WSP(); EpiQA E{B16(ws, WS_QA), (const float*)(ws + sqo), (const float*)(ws + WS_ROPE)}; run_gemm<1>(lds, wave, gw, B16(ws, WS_QL), B16(ws, wlo + WO_UQ), 768, 384, E); }
        { unsigned char* ws = WSP(); EpiKV E{B16(ws, WS_KA), B16(ws, WS_VA), (const float*)(ws + skvo)}; run_gemm<2>(lds, wave, gw, B16(ws, WS_KVL), B16(ws, wlo + WO_UKV), 1024, 256, E); }
        GRID_BAR();
        { unsigned char* ws = WSP();
          att::Tensors T{B16(ws, WS_QA), B16(ws, WS_KA), B16(ws, WS_VA), B16(ws, WS_QD), B16(ws, WS_KD), B16(ws, WS_VD), B16(ws, WS_AOA), B16(ws, WS_AOB), p.in[I_SUBLN] + L * 128, ((const float*)(ws + WS_LAM))[L], L == 0 ? 0.2f : 0.35550906759096924f, (float*)(ws + WS_O1 + (size_t)bx * 131072)};
          att::attn_phase((att::lds_ptr)lds, wave, T, vcu, G);
#ifdef PROBE_ATT2
          att::attn_phase((att::lds_ptr)lds, wave, T, vcu, G);
#endif
        }
        GRID_BAR();
        if (Mpost == MP) {
            { unsigned char* ws = WSP(); EpiGate E{B16(ws, WS_G), 0}; mini_gemm(lds, wave, B16(ws, WS_XN), B16(ws, wlo + WO_INB), 1024, 1024, E); }
            { unsigned char* ws = WSP(); EpiGate E{B16(ws, WS_G), 1024}; mini_gemm(lds, wave, B16(ws, WS_XN), B16(ws, wlo + WO_INB) + (size_t)1024 * 1024, 1024, 1024, E); }
            { unsigned char* ws = WSP(); EpiMix<false> E{B16(ws, WS_MIXIN), B16(ws, WS_G), 0}; mini_gemm(lds, wave, B16(ws, WS_AOA), B16(ws, wlo + WO_OMLA), 1024, 512, E); }
            { unsigned char* ws = WSP(); EpiMix<true> E{B16(ws, WS_MIXIN), B16(ws, WS_G), 1024}; mini_gemm(lds, wave, B16(ws, WS_AOB), B16(ws, wlo + WO_ODIFF), 1024, 512, E); }
        }
        { unsigned char* ws = WSP(); EpiGate E{B16(ws, WS_G), 0}; run_gemm_pair(lds, wave, B16(ws, WS_XN), B16(ws, wlo + WO_INB), 1024, E, 0); }
        { unsigned char* ws = WSP(); EpiMixPair E{B16(ws, WS_MIXIN), B16(ws, WS_G)}; run_gemm_pair(lds, wave, B16(ws, WS_AOA), B16(ws, wlo + WO_OMLA), 512, E, AO_PM_OFF); }
        GRID_BAR();
        { unsigned char* ws = WSP(); EpiPlain E{B16(ws, WS_MIX), 1024}; run_gemm<7>(lds, wave, gw, B16(ws, WS_MIXIN), B16(ws, wlo + WO_OUT), 1024, 1024, E, Mpost); }
        GRID_BAR();
        { unsigned char* ws = WSP(); float* RM = (float*)(ws + WS_RM);
          row_pass(gw, ngw, wave, Mpost, L == 0 ? p.in[I_X] : p.out, L == 0 ? p.in[I_META] : RM, B16(ws, WS_MIX), p.in[I_NMIXPOST] + L * DM, nullptr, nullptr, nullptr, nullptr, p.in[I_NFFNPRE] + L * DM, B16(ws, WS_XN)); }
        GRID_BAR();
        { unsigned char* ws = WSP(); EpiSwiglu E{B16(ws, WS_FF)}; run_gemm<8>(lds, wave, gw, B16(ws, WS_XN), B16(ws, wlo + WO_GU), 5632, 1024, E, Mpost); }
        GRID_BAR();
        { unsigned char* ws = WSP(); EpiPlain E{B16(ws, WS_FFO), 1024}; run_gemm<9>(lds, wave, gw, B16(ws, WS_FF), B16(ws, wlo + WO_DOWN), 1024, DFF, E, Mpost); }
        GRID_BAR();
        { unsigned char* ws = WSP(); float* RM = (float*)(ws + WS_RM);
          const float* r0x = L == 0 ? p.in[I_X] : p.out; const float* r0m = L == 0 ? p.in[I_META] : RM;
          if (L + 1 < NLAYER) row_pass(gw, ngw, wave, MP, r0x, r0m, B16(ws, WS_MIX), p.in[I_NMIXPOST] + L * DM, B16(ws, WS_FFO), p.in[I_NFFNPOST] + L * DM, p.out, RM, p.in[I_NMIXPRE] + (L + 1) * DM, B16(ws, WS_XN));
          else row_pass(gw, ngw, wave, M0, r0x, r0m, B16(ws, WS_MIX), p.in[I_NMIXPOST] + L * DM, B16(ws, WS_FFO), p.in[I_NFFNPOST] + L * DM, p.out, RM, nullptr, nullptr); }
        if (L + 1 < NLAYER) GRID_BAR();
    }
}

extern "C" void kernel_launch(void* const* d_in, const int* in_sizes, int n_in, void* d_out, int out_size, void* d_ws, size_t ws_size, hipStream_t stream) {
    static int grid = 0;
    if (grid == 0) {
        if (n_in != 18 || ws_size < WS_END) { fprintf(stderr, "kernel_launch: unexpected n_in %d / ws_size %zu\n", n_in, ws_size); grid = -1; return; }
        int dev = 0, cus = 0, per_cu = 0;
        hipGetDevice(&dev); hipDeviceGetAttribute(&cus, hipDeviceAttributeMultiprocessorCount, dev);
        if (hipFuncSetAttribute((const void*)fwd_megakernel, hipFuncAttributeMaxDynamicSharedMemorySize, LDS_BYTES) != hipSuccess) { fprintf(stderr, "kernel_launch: hipFuncSetAttribute failed\n"); grid = -1; return; }
        if (hipOccupancyMaxActiveBlocksPerMultiprocessor(&per_cu, (const void*)fwd_megakernel, 512, LDS_BYTES) != hipSuccess || per_cu < 1) { fprintf(stderr, "kernel_launch: occupancy query gave %d\n", per_cu); per_cu = 1; }
        (void)hipGetLastError();
        grid = cus < 256 ? cus : 256;
    }
    if (grid < 0) return;
    Params p{};
    for (int i = 0; i < 18; ++i) p.in[i] = (const float*)d_in[i];
    p.out = (float*)d_out; p.ws = (unsigned char*)d_ws;
    const double TWO_PI = 6.283185307179586476925286766559;
    for (int i = 0; i < 16; ++i) p.invrev[i] = pow(500000.0, -(double)i / 16.0) / TWO_PI;
    for (int i = 0; i < 8; ++i) p.invrev[16 + i] = pow(500000.0, -(double)i / 8.0) / TWO_PI;
    if (hipMemsetAsync((char*)d_ws + WS_BAR, 0, WS_BAR_BYTES, stream) != hipSuccess) { fprintf(stderr, "kernel_launch: memset failed\n"); return; }
    void* args[] = {&p};
    hipError_t e = hipLaunchCooperativeKernel((const void*)fwd_megakernel, dim3(grid), dim3(512), args, LDS_BYTES, stream);
    if (e != hipSuccess) fprintf(stderr, "cooperative launch failed: %s (grid %d)\n", hipGetErrorString(e), grid);
}
```

```cpp
#include <hip/hip_runtime.h>
#include <hip/hip_cooperative_groups.h>
#include <cstdio>
#include <cstdint>
#include <cmath>
namespace cg = cooperative_groups;
__device__ __forceinline__ int launder(int x) { asm volatile("" : "+v"(x)); return x; }
__device__ __forceinline__ int launder_s(int x) { asm volatile("" : "+s"(x)); return x; }
__device__ __forceinline__ int fresh_tid(int wave) { int z = 0; asm volatile("" : "+s"(z)); return wave * 64 + (int)__builtin_amdgcn_mbcnt_hi(~0u, __builtin_amdgcn_mbcnt_lo(~0u, (unsigned)z)); }
__device__ __forceinline__ float shx(float v, int o, int lane) { return __builtin_bit_cast(float, __builtin_amdgcn_ds_bpermute((lane ^ o) << 2, __builtin_bit_cast(int, v))); }

namespace pg8 {
#define PG8_LAS __attribute__((address_space(3)))
typedef unsigned short bf16_t;
typedef short bf16x8 __attribute__((ext_vector_type(8)));
typedef float f32x4 __attribute__((ext_vector_type(4)));
typedef unsigned u32x4 __attribute__((ext_vector_type(4)));
constexpr int BM = 256, BK = 64, HALF = 128, HTB = HALF * BK * 2  , STAGE_BYTES = 8 * HTB, NXCD = 8, WGM = 8;

__host__ __device__ __forceinline__ int lds_byte(int r, int c) { const int st = (r >> 4) * 2 + (c >> 5), rr = r & 15, cc = c & 31, ob = rr * 64 + cc * 2; return st * 1024 + (ob ^ (((ob >> 9) & 1) << 5)); }
__host__ __device__ __forceinline__ void stage_rc(int b, int& R, int& C) { const int st = b / 1024, sb = b % 1024, swz = sb ^ (((sb >> 9) & 1) << 5); R = (st >> 1) * 16 + swz / 64; C = (st & 1) * 32 + (swz % 64) / 2; }
__host__ __device__ __forceinline__ int perm32(int rho) { const int n = rho >> 4, i = rho & 15; return 8 * (i >> 2) + 4 * n + (i & 3); }

struct Unit { int pm, pn; };
struct Gemm { const bf16_t* A; const bf16_t* Bt; int M, N, K; };

struct StaticOrder {
    int nM, nN, nwg, G, c;
    __host__ __device__ void init(int M, int N, int G_, int c_) { nM = M / BM; nN = N / BM; nwg = nM * nN; G = G_; c = c_; }
    __host__ __device__ bool next(int i, Unit& u) const {
        const long L = (long)i * G + c; if (L >= nwg) return false;
        int wgid = (int)L; { const int q = nwg / NXCD, r = nwg % NXCD, xcd = wgid % NXCD, off = wgid / NXCD; wgid = (xcd < r ? xcd * (q + 1) : r * (q + 1) + (xcd - r) * q) + off; }
        const int nig = WGM * nN, gid = wgid / nig, fm = gid * WGM, gsz = (nM - fm) < WGM ? (nM - fm) : WGM;
        u.pm = fm + ((wgid % nig) % gsz); u.pn = (wgid % nig) / gsz; return true;
    }
    __device__ __forceinline__ void a_ready(const Unit&) const {}
    __device__ __forceinline__ void done(const Unit&) const {}
};

typedef float f32x2 __attribute__((ext_vector_type(2)));
typedef __bf16 bf16x2_t __attribute__((ext_vector_type(2)));
__device__ __forceinline__ unsigned cvt_pk_bf16(float lo, float hi) { f32x2 v = {lo, hi}; bf16x2_t b = __builtin_convertvector(v, bf16x2_t); return __builtin_bit_cast(unsigned, b); }
template <class Epi, class Sched, bool ALIGN_EPI = false, bool SP2 = false>
__device__ __forceinline__ void gemm_phase(PG8_LAS unsigned char* lds, const Gemm g, const Sched& S, const Epi& E, int wave_) {
    const int tid = fresh_tid(wave_), wid = __builtin_amdgcn_readfirstlane(tid >> 6), lane = tid & 63, wr = wid >> 2, wc = wid & 3, fr = lane & 15, fq = lane >> 4;
    const int K = g.K, nt = K / BK;
    unsigned voffA[2], voffB[2];
#pragma unroll
    for (int i = 0; i < 2; ++i) { int R, C; stage_rc(tid * 16 + i * 8192, R, C); const int Rb = Epi::PERM ? ((R & ~31) + perm32(R & 31)) : R;
        voffA[i] = (unsigned)(R * K + C) * 2u; voffB[i] = (unsigned)(Rb * K + C) * 2u; }
    const size_t kstep = (size_t)(BK * 2);
    const size_t hstep = (size_t)HALF * K * 2;
    const size_t tstep = 2 * hstep;
    const unsigned ldsw = (unsigned)wid * 1024u;
    const int aoff = lds_byte(wr * 64 + fr, fq * 8), boff = lds_byte(wc * 32 + fr, fq * 8);
#define PG8_SA(b, h) (((b) * 2 + (h)) * HTB)
#define PG8_SB(b, h) ((4 + (b) * 2 + (h)) * HTB)
#define PG8_STAGE(bufoff, gbase, voff) do { _Pragma("unroll") for (int _i = 0; _i < 2; ++_i) \
        __builtin_amdgcn_global_load_lds((const unsigned*)((const char*)(gbase) + (voff)[_i]), (PG8_LAS unsigned*)(lds + (bufoff) + ldsw + _i * 8192), 16, 0, 0); } while (0)
#define PG8_LDA(dst, b, h) do { _Pragma("unroll") for (int m = 0; m < 4; ++m) _Pragma("unroll") for (int k = 0; k < 2; ++k) dst[m][k] = *(const PG8_LAS bf16x8*)(lds + PG8_SA(b, h) + aoff + m * 2048 + k * 1024); } while (0)
#define PG8_LDB(dst, b, h) do { _Pragma("unroll") for (int n = 0; n < 2; ++n) _Pragma("unroll") for (int k = 0; k < 2; ++k) dst[n][k] = *(const PG8_LAS bf16x8*)(lds + PG8_SB(b, h) + boff + n * 2048 + k * 1024); } while (0)
#define PG8_MMA(ai, bj, At, Bt) do { __builtin_amdgcn_s_setprio(1); _Pragma("unroll") for (int m = 0; m < 4; ++m) _Pragma("unroll") for (int n = 0; n < 2; ++n) _Pragma("unroll") for (int k = 0; k < 2; ++k) \
        acc[ai][bj][m][n] = __builtin_amdgcn_mfma_f32_16x16x32_bf16(Bt[n][k], At[m][k], acc[ai][bj][m][n], 0, 0, 0); __builtin_amdgcn_s_setprio(0); } while (0)
#define PG8_WAIT_V(n) asm volatile("s_waitcnt vmcnt(" #n ")" ::: "memory")
#define PG8_WAIT_L(n) asm volatile("s_waitcnt lgkmcnt(" #n ")" ::: "memory")
#define PG8_BAR __builtin_amdgcn_s_barrier()
#define PG8_SCHED __builtin_amdgcn_sched_barrier(0)
    Unit cur, nxt; int ui = 0;
    if (!S.next(0, cur)) return;
    f32x4 acc[2][2][4][2];
#pragma unroll
    for (int a = 0; a < 2; ++a)
#pragma unroll
        for (int b = 0; b < 2; ++b)
#pragma unroll
            for (int m = 0; m < 4; ++m)
#pragma unroll
                for (int n = 0; n < 2; ++n) acc[a][b][m][n] = (f32x4){0.f, 0.f, 0.f, 0.f};
    bf16x8 At[4][2], B0[2][2], B1[2][2];
    const char* cA = (const char*)g.A + (size_t)cur.pm * tstep; const char* cB = (const char*)g.Bt + (size_t)cur.pn * tstep;
    S.a_ready(cur);
    if constexpr (SP2) {
        PG8_STAGE(PG8_SB(0, 0), cB, voffB); PG8_STAGE(PG8_SB(0, 1), cB + hstep, voffB); PG8_STAGE(PG8_SA(0, 0), cA, voffA); PG8_STAGE(PG8_SA(0, 1), cA + hstep, voffA);
        if (wr == 1) PG8_BAR;
        PG8_WAIT_V(2); PG8_BAR;
        PG8_STAGE(PG8_SB(1, 0), cB + kstep, voffB); PG8_STAGE(PG8_SA(1, 0), cA + kstep, voffA); PG8_STAGE(PG8_SB(1, 1), cB + hstep + kstep, voffB);
        PG8_WAIT_V(6); PG8_BAR;
    } else {
        PG8_STAGE(PG8_SB(0, 0), cB, voffB); PG8_STAGE(PG8_SA(0, 0), cA, voffA); PG8_STAGE(PG8_SB(0, 1), cB + hstep, voffB); PG8_STAGE(PG8_SA(0, 1), cA + hstep, voffA);
        if (wr == 1) PG8_BAR;
        PG8_WAIT_V(4); PG8_BAR;
        PG8_STAGE(PG8_SB(1, 0), cB + kstep, voffB); PG8_STAGE(PG8_SA(1, 0), cA + kstep, voffA); PG8_STAGE(PG8_SB(1, 1), cB + hstep + kstep, voffB);
        PG8_WAIT_V(6); PG8_BAR;
    }
    for (;;) {
        const bool has_next = S.next(ui + 1, nxt);
        const char* nA = has_next ? (const char*)g.A + (size_t)nxt.pm * tstep : cA; const char* nB = has_next ? (const char*)g.Bt + (size_t)nxt.pn * tstep : cB;
        for (int t = 0; t < nt; t += 2) {
            const bool last = (t == nt - 2);
            const char* a1 = cA + (size_t)(t + 1) * kstep;
            const char* a2 = last ? nA : cA + (size_t)(t + 2) * kstep; const char* b2 = last ? nB : cB + (size_t)(t + 2) * kstep;
            const char* a3 = a2 + kstep; const char* b3 = b2 + kstep;
            if (last && has_next) S.a_ready(nxt);
            if constexpr (SP2) {
            PG8_LDB(B0, 0, 0); PG8_LDB(B1, 0, 1); PG8_SCHED; PG8_LDA(At, 0, 0); PG8_STAGE(PG8_SA(1, 1), a1 + hstep, voffA);
            PG8_WAIT_V(8); PG8_WAIT_L(0); PG8_BAR; PG8_MMA(0, 0, At, B0); PG8_MMA(0, 1, At, B1); PG8_BAR; PG8_SCHED;
            PG8_LDA(At, 0, 1); PG8_STAGE(PG8_SB(0, 0), b2, voffB); PG8_STAGE(PG8_SB(0, 1), b2 + hstep, voffB); PG8_STAGE(PG8_SA(0, 0), a2, voffA);
            PG8_WAIT_V(8); PG8_WAIT_L(0); PG8_BAR; PG8_MMA(1, 0, At, B0); PG8_MMA(1, 1, At, B1); PG8_BAR; PG8_SCHED;
            PG8_LDB(B0, 1, 0); PG8_LDB(B1, 1, 1); PG8_SCHED; PG8_LDA(At, 1, 0); PG8_STAGE(PG8_SA(0, 1), a2 + hstep, voffA);
            PG8_WAIT_V(8); PG8_WAIT_L(0); PG8_BAR; PG8_MMA(0, 0, At, B0); PG8_MMA(0, 1, At, B1); PG8_BAR; PG8_SCHED;
            PG8_LDA(At, 1, 1); PG8_STAGE(PG8_SB(1, 0), b3, voffB); PG8_STAGE(PG8_SB(1, 1), b3 + hstep, voffB); PG8_STAGE(PG8_SA(1, 0), a3, voffA);
            PG8_WAIT_V(8); PG8_WAIT_L(0); PG8_BAR; PG8_MMA(1, 0, At, B0); PG8_MMA(1, 1, At, B1); PG8_BAR; PG8_SCHED;
            } else {
            PG8_LDB(B0, 0, 0); PG8_SCHED; PG8_LDA(At, 0, 0); PG8_STAGE(PG8_SA(1, 1), a1 + hstep, voffA);
            PG8_WAIT_L(8); PG8_BAR; PG8_WAIT_L(0); PG8_MMA(0, 0, At, B0); PG8_BAR; PG8_SCHED;
            PG8_LDB(B1, 0, 1); PG8_STAGE(PG8_SB(0, 0), b2, voffB);
            PG8_BAR; PG8_WAIT_L(0); PG8_MMA(0, 1, At, B1); PG8_BAR;
            PG8_LDA(At, 0, 1); PG8_STAGE(PG8_SA(0, 0), a2, voffA);
            PG8_BAR; PG8_WAIT_L(0); PG8_MMA(1, 0, At, B0); PG8_BAR; PG8_SCHED;
            PG8_STAGE(PG8_SB(0, 1), b2 + hstep, voffB);
            PG8_WAIT_V(6); PG8_BAR; PG8_MMA(1, 1, At, B1); PG8_BAR;
            PG8_LDB(B0, 1, 0); PG8_SCHED; PG8_LDA(At, 1, 0); PG8_STAGE(PG8_SA(0, 1), a2 + hstep, voffA);
            PG8_WAIT_L(8); PG8_BAR; PG8_WAIT_L(0); PG8_MMA(0, 0, At, B0); PG8_BAR; PG8_SCHED;
            PG8_LDB(B1, 1, 1); PG8_STAGE(PG8_SB(1, 0), b3, voffB);
            PG8_BAR; PG8_WAIT_L(0); PG8_MMA(0, 1, At, B1); PG8_BAR;
            PG8_LDA(At, 1, 1); PG8_STAGE(PG8_SA(1, 0), a3, voffA);
            PG8_BAR; PG8_WAIT_L(0); PG8_MMA(1, 0, At, B0); PG8_BAR; PG8_SCHED;
            PG8_STAGE(PG8_SB(1, 1), b3 + hstep, voffB);
            PG8_WAIT_V(6); PG8_BAR; PG8_MMA(1, 1, At, B1); PG8_BAR;
            }
        }
        if constexpr (ALIGN_EPI) { if (wr == 0) PG8_BAR; }
        if constexpr (!Epi::AFTER_DRAIN) { E(acc, cur, wr, wc, fr, fq); S.done(cur); }
        if (!has_next) break;
#pragma unroll
        for (int a = 0; a < 2; ++a)
#pragma unroll
            for (int b = 0; b < 2; ++b)
#pragma unroll
                for (int m = 0; m < 4; ++m)
#pragma unroll
                    for (int n = 0; n < 2; ++n) acc[a][b][m][n] = (f32x4){0.f, 0.f, 0.f, 0.f};
        cur = nxt; cA = nA; cB = nB; ++ui;
        if constexpr (ALIGN_EPI) { if (wr == 1) PG8_BAR; }
    }
    PG8_WAIT_V(0);
    if constexpr (!ALIGN_EPI) { if (wr == 0) PG8_BAR; }
    PG8_BAR;
    if constexpr (Epi::AFTER_DRAIN) { E.fused(acc, cur, wr, wc, fr, fq, lds, wid, lane); S.done(cur); }
#undef PG8_SA
#undef PG8_SB
#undef PG8_STAGE
#undef PG8_LDA
#undef PG8_LDB
#undef PG8_MMA
#undef PG8_WAIT_V
#undef PG8_WAIT_L
#undef PG8_BAR
#undef PG8_SCHED
}
}

using pg8::bf16_t; using pg8::f32x4; using pg8::u32x4; using pg8::bf16x8; using pg8::Unit; using pg8::cvt_pk_bf16;
#define LAS __attribute__((address_space(3)))
constexpr int DM = 1024, NB = 8, SEQ = 4096, NMETA = 16, M0 = NB * SEQ  , MP = M0 + 256  , MVALID = M0 + NMETA;
constexpr int DFF = 2816, NLAYER = 2;
constexpr float EPS = 1e-6f, LOG2E = 1.4426950408889634f;
constexpr float MLA_QSCALE = 0.10206207261596575f * LOG2E;
constexpr float DIFF_QSCALE = 0.125f * LOG2E;
constexpr int NPOS = 4352;
enum { I_X = 0, I_META, I_NMIXPRE, I_NMIXPOST, I_NFFNPRE, I_NFFNPOST, I_WIN, I_QNORM, I_KVNORM, I_WUQ, I_WUKV, I_WOMLA, I_LAMBDA, I_SUBLN, I_WODIFF, I_WOUT, I_WGU, I_WDOWN };
constexpr size_t QMiB = 1u << 18;
constexpr size_t WS_BAR = 14 * QMiB  , WS_BAR_BYTES = 16384;
constexpr size_t WS_LAM = 0, WS_ROPE = 4096, WS_SSQQ = 4 * QMiB  , WS_SSQKV = 9 * QMiB  , WS_RM = 12 * QMiB, WS_W = 16 * QMiB, WS_WSTRIDE = 124 * QMiB;
constexpr size_t WO_INA = 0, WO_INB = 18 * QMiB, WO_UQ = 34 * QMiB, WO_UKV = 37 * QMiB, WO_OMLA = 40 * QMiB, WO_ODIFF = 44 * QMiB, WO_OUT = 48 * QMiB, WO_GU = 56 * QMiB, WO_DOWN = 100 * QMiB;
constexpr size_t WS_XN = 264 * QMiB;
constexpr size_t WS_QD = 524 * QMiB, WS_KD = 654 * QMiB, WS_VD = 784 * QMiB, WS_QA = 914 * QMiB, WS_KA = 1109 * QMiB, WS_VA = 1304 * QMiB, WS_QL = 1434 * QMiB, WS_KVL = 1532 * QMiB;
constexpr size_t WS_AOA = 1600 * QMiB, WS_AOB = 1730 * QMiB, WS_G = 524 * QMiB, WS_MIXIN = 1044 * QMiB, WS_MIX = 1304 * QMiB, WS_FF = 524 * QMiB, WS_FFO = 1600 * QMiB  ;
constexpr size_t WS_O1 = 1860 * QMiB;
constexpr size_t WS_END = 1988 * QMiB;
static_assert(WS_QD + (size_t)MP * 512 * 2 <= WS_KD && WS_KD + (size_t)MP * 512 * 2 <= WS_VD && WS_VD + (size_t)MP * 512 * 2 <= WS_QA && WS_QA + (size_t)MP * 768 * 2 <= WS_KA && WS_KA + (size_t)MP * 768 * 2 <= WS_VA, "map1");
static_assert(WS_VA + (size_t)MP * 512 * 2 <= WS_QL && WS_QL + (size_t)MP * 384 * 2 <= WS_KVL && WS_KVL + (size_t)MP * 256 * 2 <= WS_AOA && WS_AOA + (size_t)MP * 512 * 2 <= WS_AOB && WS_AOB + (size_t)MP * 512 * 2 <= WS_O1, "map2");
static_assert(WS_G + (size_t)MP * 2048 * 2 <= WS_MIXIN && WS_MIXIN + (size_t)MP * 1024 * 2 <= WS_MIX && WS_MIX + (size_t)MP * 1024 * 2 <= WS_AOA && WS_FF + (size_t)MP * DFF * 2 <= WS_MIX && WS_FFO + (size_t)MP * 1024 * 2 <= WS_O1 && WS_XN + (size_t)MP * 1024 * 2 <= WS_QD, "map3");
static_assert(WO_INA + 2304 * 1024 * 2 <= WO_INB && WO_INB + 2048 * 1024 * 2 <= WO_UQ && WO_UQ + 768 * 384 * 2 <= WO_UKV && WO_UKV + 1024 * 256 * 2 <= WO_OMLA && WO_GU + 5632 * 1024 * 2 <= WO_DOWN && WO_DOWN + 1024 * 2816 * 2 <= WS_WSTRIDE, "wmap");
static_assert(WS_W + 2 * WS_WSTRIDE <= WS_XN && WS_ROPE + (size_t)NPOS * 24 * 8 <= WS_SSQQ && WS_SSQQ + (size_t)MP * 8 * 4 <= WS_SSQKV && WS_SSQKV + (size_t)MP * 4 * 4 <= WS_RM, "map4");

struct Params { const float* in[18]; float* out; unsigned char* ws; double invrev[24]; };

__device__ __forceinline__ unsigned f2bf(float f) { unsigned u = __builtin_bit_cast(unsigned, f); return (u + 0x7fffu + ((u >> 16) & 1u)) >> 16; }
__device__ __forceinline__ unsigned pk2(float lo, float hi) { return f2bf(lo) | (f2bf(hi) << 16); }
__device__ __forceinline__ float bflo(unsigned w) { return __builtin_bit_cast(float, w << 16); }
__device__ __forceinline__ float bfhi(unsigned w) { return __builtin_bit_cast(float, w & 0xffff0000u); }
__device__ __forceinline__ void st8(bf16_t* p, f32x4 v0, f32x4 v1) {
    u32x4 w; w.x = cvt_pk_bf16(v0[0], v0[1]); w.y = cvt_pk_bf16(v0[2], v0[3]); w.z = cvt_pk_bf16(v1[0], v1[1]); w.w = cvt_pk_bf16(v1[2], v1[3]); *(u32x4*)p = w; }
__device__ __forceinline__ void ld8(const bf16_t* p, f32x4& v0, f32x4& v1) {
    const u32x4 w = __builtin_nontemporal_load((const u32x4*)p); v0 = (f32x4){bflo(w.x), bfhi(w.x), bflo(w.y), bfhi(w.y)}; v1 = (f32x4){bflo(w.z), bfhi(w.z), bflo(w.w), bfhi(w.w)}; }
__device__ __forceinline__ float sigmoidf_(float x) { return __builtin_amdgcn_rcpf(1.0f + __builtin_amdgcn_exp2f(-x * LOG2E)); }
__device__ __forceinline__ int row_pos(int row) { return row < M0 ? NMETA + (row & (SEQ - 1)) : row - M0; }
__device__ __forceinline__ void rope4(f32x4& v0, f32x4& v1, const float* t) {
    const f32x4 c0 = *(const f32x4*)t, c1 = *(const f32x4*)(t + 4);
    float a, b;
    a = v0[0]; b = v0[1]; v0[0] = a * c0[0] - b * c0[1]; v0[1] = b * c0[0] + a * c0[1];
    a = v0[2]; b = v0[3]; v0[2] = a * c0[2] - b * c0[3]; v0[3] = b * c0[2] + a * c0[3];
    a = v1[0]; b = v1[1]; v1[0] = a * c1[0] - b * c1[1]; v1[1] = b * c1[0] + a * c1[1];
    a = v1[2]; b = v1[3]; v1[2] = a * c1[2] - b * c1[3]; v1[3] = b * c1[2] + a * c1[3];
}
__device__ __forceinline__ float sumsq4(f32x4 v) { return (v[0] * v[0] + v[1] * v[1]) + (v[2] * v[2] + v[3] * v[3]); }
__device__ __forceinline__ float wave_sum(float v, int lane) {
#pragma unroll
    for (int o = 1; o < 64; o <<= 1) v += shx(v, o, lane);
    return v;
}

typedef const f32x4 (&AccRef)[2][2][4][2];
struct EpiPlain {
    static constexpr bool PERM = true, AFTER_DRAIN = false;
    bf16_t* O; int ldc;
    __device__ __forceinline__ void operator()(AccRef acc, const Unit& u, int wr, int wc, int fr_, int fq_) const { run<false>(acc, u, wr, wc, fr_, fq_); }
    template <bool MINI> __device__ __forceinline__ void run(AccRef acc, const Unit& u, int wr, int wc, int fr_, int fq_) const {
        const int ln_ = fresh_tid(0), fr = ln_ & 15, fq = ln_ >> 4; (void)fr_; (void)fq_;
        const int row0 = u.pm * 256 + wr * 64 + fr, colw = u.pn * 256 + wc * 32 + 8 * fq;
#pragma unroll
        for (int ai = 0; ai < (MINI ? 1 : 2); ++ai)
#pragma unroll
            for (int m = 0; m < (MINI ? 1 : 4); ++m) { const int row = row0 + ai * 128 + m * 16;
#pragma unroll
                for (int bj = 0; bj < 2; ++bj) st8(O + (size_t)row * ldc + colw + bj * 128, acc[ai][bj][m][0], acc[ai][bj][m][1]); }
    }
};
struct EpiInA {
    static constexpr bool PERM = true, AFTER_DRAIN = false;
    bf16_t *QD, *KD, *VD, *KVL, *QL, *KA; float *ssq_q, *ssq_kv; const float* rope;
    template <bool MINI> static __device__ __forceinline__ void lat(AccRef acc, bf16_t* dst, int ld, float* sq, int nslot, int slot, int row0, int cw, int fr, int fq) {
#pragma unroll
        for (int ai = 0; ai < (MINI ? 1 : 2); ++ai)
#pragma unroll
            for (int m = 0; m < (MINI ? 1 : 4); ++m) { const int row = row0 + ai * 128 + m * 16; float s = 0.f;
#pragma unroll
                for (int bj = 0; bj < 2; ++bj) { const f32x4 v0 = acc[ai][bj][m][0], v1 = acc[ai][bj][m][1]; s += sumsq4(v0) + sumsq4(v1); st8(dst + (size_t)row * ld + bj * 128 + cw, v0, v1); }
                s += shx(s, 16, fr + 16 * fq); s += shx(s, 32, fr + 16 * fq);
                if (fq == 0) sq[(size_t)row * nslot + slot] = s; }
    }
    __device__ __forceinline__ void operator()(AccRef acc, const Unit& u, int wr, int wc, int fr_, int fq_) const { run<false>(acc, u, wr, wc, fr_, fq_); }
    template <bool MINI> __device__ __forceinline__ void run(AccRef acc, const Unit& u, int wr, int wc, int fr_, int fq_) const {
        const int ln_ = fresh_tid(0), fr = ln_ & 15, fq = ln_ >> 4; (void)fr_; (void)fq_;
        const int pn = u.pn, row0 = u.pm * 256 + wr * 64 + fr, cw = wc * 32 + 8 * fq;
        if (pn < 6) {
            static_assert(WS_KD - WS_QD == WS_VD - WS_KD, "QD/KD/VD equally spaced");
            bf16_t* dst = QD + (size_t)(pn >> 1) * ((WS_KD - WS_QD) / 2);
            const int cbase = (pn & 1) * 256;
            const bool dorope = (pn < 4) && ((wc & 1) == 0) && (fq < 2);
            const float sc = pn < 2 ? DIFF_QSCALE : 1.0f;
#pragma unroll
            for (int ai = 0; ai < (MINI ? 1 : 2); ++ai)
#pragma unroll
                for (int m = 0; m < (MINI ? 1 : 4); ++m) { const int row = row0 + ai * 128 + m * 16; const float* rt = rope + (size_t)row_pos(row) * 48 + 2 * (16 + 4 * fq);
#pragma unroll
                    for (int bj = 0; bj < 2; ++bj) { f32x4 v0 = acc[ai][bj][m][0], v1 = acc[ai][bj][m][1];
                        if (dorope) rope4(v0, v1, rt);
                        v0 = v0 * sc; v1 = v1 * sc; st8(dst + (size_t)row * 512 + cbase + bj * 128 + cw, v0, v1); } }
        } else if (pn == 6) { lat<MINI>(acc, KVL, 256, ssq_kv, 4, wc, row0, cw, fr, fq);
        } else if (pn == 7) { lat<MINI>(acc, QL, 384, ssq_q, 8, wc, row0, cw, fr, fq);
        } else {
#pragma unroll
            for (int ai = 0; ai < (MINI ? 1 : 2); ++ai)
#pragma unroll
                for (int m = 0; m < (MINI ? 1 : 4); ++m) { const int row = row0 + ai * 128 + m * 16;
                    { const f32x4 v0 = acc[ai][0][m][0], v1 = acc[ai][0][m][1]; float s = sumsq4(v0) + sumsq4(v1); st8(QL + (size_t)row * 384 + 256 + cw, v0, v1);
                      s += shx(s, 16, fr + 16 * fq); s += shx(s, 32, fr + 16 * fq);
                      if (fq == 0) ssq_q[(size_t)row * 8 + 4 + wc] = s; }
                    if (wc == 0) { f32x4 v0 = acc[ai][1][m][0], v1 = acc[ai][1][m][1]; rope4(v0, v1, rope + (size_t)row_pos(row) * 48 + 2 * (4 * fq));
                        u32x4 w; w.x = cvt_pk_bf16(v0[0], v0[1]); w.y = cvt_pk_bf16(v0[2], v0[3]); w.z = cvt_pk_bf16(v1[0], v1[1]); w.w = cvt_pk_bf16(v1[2], v1[3]);
#pragma unroll
                        for (int h = 0; h < 8; ++h) *(u32x4*)(KA + (size_t)row * 768 + h * 96 + 64 + 8 * fq) = w; } }
        }
    }
};
struct EpiQA {
    static constexpr bool PERM = true, AFTER_DRAIN = false;
    bf16_t* QA; const float* ssq_q; const float* rope;
    __device__ __forceinline__ void operator()(AccRef acc, const Unit& u, int wr, int wc, int fr_, int fq_) const { run<false>(acc, u, wr, wc, fr_, fq_); }
    template <bool MINI> __device__ __forceinline__ void run(AccRef acc, const Unit& u, int wr, int wc, int fr_, int fq_) const {
        const int ln_ = fresh_tid(0), fr = ln_ & 15, fq = ln_ >> 4; (void)fr_; (void)fq_;
        const int row0 = u.pm * 256 + wr * 64 + fr, colw = u.pn * 256 + wc * 32 + 8 * fq;
#pragma unroll
        for (int ai = 0; ai < (MINI ? 1 : 2); ++ai)
#pragma unroll
            for (int m = 0; m < (MINI ? 1 : 4); ++m) { const int row = row0 + ai * 128 + m * 16; const f32x4 sa = *(const f32x4*)(ssq_q + (size_t)row * 8), sb = *(const f32x4*)(ssq_q + (size_t)row * 8 + 4); const float rs = rsqrtf((((sa[0] + sa[1]) + (sa[2] + sa[3])) + ((sb[0] + sb[1]) + (sb[2] + sb[3]))) * (1.0f / 384.0f) + EPS) * MLA_QSCALE; const float* rt = rope + (size_t)row_pos(row) * 48;
#pragma unroll
                for (int bj = 0; bj < 2; ++bj) { const int col = colw + bj * 128, j = col % 96; f32x4 v0 = acc[ai][bj][m][0] * rs, v1 = acc[ai][bj][m][1] * rs;
                    if (j >= 64) rope4(v0, v1, rt + (j - 64));
                    st8(QA + (size_t)row * 768 + col, v0, v1); } }
    }
};
struct EpiKV {
    static constexpr bool PERM = true, AFTER_DRAIN = false;
    bf16_t *KA, *VA; const float* ssq_kv;
    __device__ __forceinline__ void operator()(AccRef acc, const Unit& u, int wr, int wc, int fr_, int fq_) const { run<false>(acc, u, wr, wc, fr_, fq_); }
    template <bool MINI> __device__ __forceinline__ void run(AccRef acc, const Unit& u, int wr, int wc, int fr_, int fq_) const {
        const int ln_ = fresh_tid(0), fr = ln_ & 15, fq = ln_ >> 4; (void)fr_; (void)fq_;
        const int row0 = u.pm * 256 + wr * 64 + fr, colw = u.pn * 256 + wc * 32 + 8 * fq;
#pragma unroll
        for (int ai = 0; ai < (MINI ? 1 : 2); ++ai)
#pragma unroll
            for (int m = 0; m < (MINI ? 1 : 4); ++m) { const int row = row0 + ai * 128 + m * 16; const f32x4 sa = *(const f32x4*)(ssq_kv + (size_t)row * 4); const float rs = rsqrtf(((sa[0] + sa[1]) + (sa[2] + sa[3])) * (1.0f / 256.0f) + EPS);
#pragma unroll
                for (int bj = 0; bj < 2; ++bj) { const int c = colw + bj * 128; const f32x4 v0 = acc[ai][bj][m][0] * rs, v1 = acc[ai][bj][m][1] * rs;
                    bf16_t* dst = (u.pn < 2) ? KA + (size_t)row * 768 + (c >> 6) * 96 + (c & 63) : VA + (size_t)row * 512 + (c - 512);
                    st8(dst, v0, v1); } }
    }
};
struct EpiGate {
    static constexpr bool PERM = true, AFTER_DRAIN = false;
    bf16_t* G; int goff;
    __device__ __forceinline__ void operator()(AccRef acc, const Unit& u, int wr, int wc, int fr_, int fq_) const { run<false>(acc, u, wr, wc, fr_, fq_); }
    template <bool MINI> __device__ __forceinline__ void run(AccRef acc, const Unit& u, int wr, int wc, int fr_, int fq_) const {
        const int ln_ = fresh_tid(0), fr = ln_ & 15, fq = ln_ >> 4; (void)fr_; (void)fq_;
        const int row0 = u.pm * 256 + wr * 64 + fr, colw = u.pn * 256 + wc * 32 + 8 * fq;
#pragma unroll
        for (int ai = 0; ai < (MINI ? 1 : 2); ++ai)
#pragma unroll
            for (int m = 0; m < (MINI ? 1 : 4); ++m) { const int row = row0 + ai * 128 + m * 16;
#pragma unroll
                for (int bj = 0; bj < 2; ++bj) { f32x4 v0 = acc[ai][bj][m][0], v1 = acc[ai][bj][m][1];
#pragma unroll
                    for (int e = 0; e < 4; ++e) { v0[e] = sigmoidf_(v0[e]); v1[e] = sigmoidf_(v1[e]); }
                    st8(G + (size_t)row * 2048 + goff + colw + bj * 128, v0, v1); } }
    }
};
template <bool ADD> struct EpiMix {
    static constexpr bool PERM = true, AFTER_DRAIN = false;
    bf16_t* MIXIN; const bf16_t* G; int goff;
    __device__ __forceinline__ void operator()(AccRef acc, const Unit& u, int wr, int wc, int fr_, int fq_) const { run<false>(acc, u, wr, wc, fr_, fq_); }
    template <bool MINI> __device__ __forceinline__ void run(AccRef acc, const Unit& u, int wr, int wc, int fr_, int fq_) const {
        const int ln_ = fresh_tid(0), fr = ln_ & 15, fq = ln_ >> 4; (void)fr_; (void)fq_;
        const int row0 = u.pm * 256 + wr * 64 + fr, colw = u.pn * 256 + wc * 32 + 8 * fq;
#pragma unroll
        for (int ai = 0; ai < (MINI ? 1 : 2); ++ai)
#pragma unroll
            for (int m = 0; m < (MINI ? 1 : 4); ++m) { const int row = row0 + ai * 128 + m * 16;
#pragma unroll
                for (int bj = 0; bj < 2; ++bj) { const int col = colw + bj * 128; f32x4 g0, g1; ld8(G + (size_t)row * 2048 + goff + col, g0, g1);
                    f32x4 v0 = acc[ai][bj][m][0] * g0, v1 = acc[ai][bj][m][1] * g1;
                    if (ADD) { f32x4 p0, p1; ld8(MIXIN + (size_t)row * 1024 + col, p0, p1); v0 = v0 + p0; v1 = v1 + p1; }
                    st8(MIXIN + (size_t)row * 1024 + col, v0, v1); } }
    }
};
struct EpiSwiglu {
    static constexpr bool PERM = true, AFTER_DRAIN = false;
    bf16_t* FF;
    __device__ __forceinline__ void operator()(AccRef acc, const Unit& u, int wr, int wc, int fr_, int fq_) const { run<false>(acc, u, wr, wc, fr_, fq_); }
    template <bool MINI> __device__ __forceinline__ void run(AccRef acc, const Unit& u, int wr, int wc, int fr_, int fq_) const {
        const int ln_ = fresh_tid(0), fr = ln_ & 15, fq = ln_ >> 4; (void)fr_; (void)fq_;
        const int row0 = u.pm * 256 + wr * 64 + fr, col = u.pn * 128 + wc * 32 + 8 * fq;
#pragma unroll
        for (int ai = 0; ai < (MINI ? 1 : 2); ++ai)
#pragma unroll
            for (int m = 0; m < (MINI ? 1 : 4); ++m) { const int row = row0 + ai * 128 + m * 16;
                f32x4 g0 = acc[ai][0][m][0], g1 = acc[ai][0][m][1]; const f32x4 u0 = acc[ai][1][m][0], u1 = acc[ai][1][m][1];
#pragma unroll
                for (int e = 0; e < 4; ++e) { g0[e] = g0[e] * sigmoidf_(g0[e]) * u0[e]; g1[e] = g1[e] * sigmoidf_(g1[e]) * u1[e]; }
                st8(FF + (size_t)row * DFF + col, g0, g1); }
    }
};

template <class Epi> __device__ __forceinline__ void mini_gemm(LAS unsigned char* lds, int wave_, const bf16_t* __restrict__ A, const bf16_t* __restrict__ Bt, int N, int K, const Epi& E) {
    const int nunits = (N / 256) * 4, mu = launder_s((int)gridDim.x - 1 - (int)blockIdx.x);
    if (mu >= nunits) return;
    const int pn = mu >> 2, wc = mu & 3, lane = fresh_tid(0), fr = lane & 15, fq = lane >> 4;
    const int wave = launder_s(wave_); const bool w0 = wave == 0;
    f32x4 acc[2][2][4][2];
#pragma unroll
    for (int bj = 0; bj < 2; ++bj)
#pragma unroll
        for (int n = 0; n < 2; ++n) acc[0][bj][0][n] = (f32x4){0.f, 0.f, 0.f, 0.f};
    const bf16_t* ap = A + (size_t)(M0 + fr) * K + 8 * fq;
    const bf16_t* bp = Bt + (size_t)(256 * pn + 32 * wc + 8 * (fr >> 2) + (fr & 3)) * K + 8 * fq;
    for (int kb0 = 32 * wave; kb0 < K; kb0 += 1024) {
        bf16x8 a[4], b[4][4];
#pragma unroll
        for (int t = 0; t < 4; ++t) { const int k0 = kb0 + 256 * t;
            if (k0 < K) { a[t] = *(const bf16x8*)(ap + k0);
#pragma unroll
                for (int q = 0; q < 4; ++q) b[t][q] = *(const bf16x8*)(bp + (size_t)(128 * (q >> 1) + 4 * (q & 1)) * K + k0); } }
#pragma unroll
        for (int t = 0; t < 4; ++t) { const int k0 = kb0 + 256 * t;
            if (k0 < K) {
#pragma unroll
                for (int q = 0; q < 4; ++q) acc[0][q >> 1][0][q & 1] = __builtin_amdgcn_mfma_f32_16x16x32_bf16(b[t][q], a[t], acc[0][q >> 1][0][q & 1], 0, 0, 0); } }
    }
    LAS f32x4* part = (LAS f32x4*)lds;
#pragma unroll
    for (int bj = 0; bj < 2; ++bj)
#pragma unroll
        for (int n = 0; n < 2; ++n) part[(wave * 4 + bj * 2 + n) * 64 + lane] = acc[0][bj][0][n];
    __syncthreads();
    if (w0) {
#pragma unroll
        for (int bj = 0; bj < 2; ++bj)
#pragma unroll
            for (int n = 0; n < 2; ++n) { f32x4 t = part[(bj * 2 + n) * 64 + lane];
#pragma unroll
                for (int w = 1; w < 8; ++w) t = t + part[(w * 4 + bj * 2 + n) * 64 + lane];
                acc[0][bj][0][n] = t; }
    }
    __syncthreads();
    if (w0) { const Unit u{M0 / 256, pn}; E.template run<true>(acc, u, 0, wc, fr, fq); }
}

struct PairOrder {
    pg8::StaticOrder S; int pm_off;
    __device__ bool next(int i, Unit& u) const { if (!S.next(i >> 1, u)) return false; if (i & 1) { u.pm += pm_off; u.pn += 4; } return true; }
    __device__ __forceinline__ void a_ready(const Unit&) const {}
    __device__ __forceinline__ void done(const Unit&) const {}
};
constexpr int AO_PM_OFF = (int)((WS_AOB - WS_AOA) / (256 * 512 * 2));
static_assert((WS_AOB - WS_AOA) % (256 * 512 * 2) == 0 && AO_PM_OFF >= 129 && WO_ODIFF - WO_OMLA == 1024 * 512 * 2, "the paired branch projections address AOB / W_o_diff as row tiles behind AOA / W_o_mla");
struct EpiMixPair {
    static constexpr bool PERM = true, AFTER_DRAIN = false;
    bf16_t* MIXIN; const bf16_t* G;
    __device__ __forceinline__ void operator()(AccRef acc, const Unit& u, int wr, int wc, int fr_, int fq_) const {
        const int ln_ = fresh_tid(0), fr = ln_ & 15, fq = ln_ >> 4; (void)fr_; (void)fq_;
        const bool second = u.pn >= 4; const int pm = second ? u.pm - AO_PM_OFF : u.pm, pn = second ? u.pn - 4 : u.pn, goff = second ? 1024 : 0;
        const int row0 = pm * 256 + wr * 64 + fr, colw = pn * 256 + wc * 32 + 8 * fq;
#pragma unroll
        for (int ai = 0; ai < 2; ++ai)
#pragma unroll
            for (int m = 0; m < 4; ++m) { const int row = row0 + ai * 128 + m * 16;
#pragma unroll
                for (int bj = 0; bj < 2; ++bj) { const int col = colw + bj * 128; f32x4 g0, g1; ld8(G + (size_t)row * 2048 + goff + col, g0, g1);
                    f32x4 v0 = acc[ai][bj][m][0] * g0, v1 = acc[ai][bj][m][1] * g1;
                    if (second) { f32x4 p0, p1; ld8(MIXIN + (size_t)row * 1024 + col, p0, p1); v0 = v0 + p0; v1 = v1 + p1; }
                    st8(MIXIN + (size_t)row * 1024 + col, v0, v1); } }
    }
};
template <class Epi> __device__ __forceinline__ void run_gemm_pair(LAS unsigned char* lds, int wave, const bf16_t* A, const bf16_t* Bt, int K, const Epi& E, int pm_off) {
    pg8::Gemm g{A, Bt, M0, 1024, K}; PairOrder S; S.S.init(M0, 1024, launder_s((int)gridDim.x), launder_s((int)blockIdx.x)); S.pm_off = pm_off;
#ifndef NO_GEMM
    pg8::gemm_phase<Epi, PairOrder, true, true>(lds, g, S, E, wave);
#endif
}
#ifndef ONLY_GEMM
#define ONLY_GEMM -1
#endif
#ifndef PROBE_GEMM_MASK
#define PROBE_GEMM_MASK 0
#endif
#ifndef PROBE_GEMM_REP
#define PROBE_GEMM_REP 1
#endif
template <int ID, class Epi> __device__ __forceinline__ void run_gemm1(LAS unsigned char* lds, int wave, int gwave, const bf16_t* A, const bf16_t* Bt, int N, int K, const Epi& E, int Mrows) {
    if (Mrows == MP) mini_gemm(lds, wave, A, Bt, N, K, E);
    pg8::Gemm g{A, Bt, M0, N, K}; pg8::StaticOrder S; S.init(M0, N, launder_s((int)gridDim.x), launder_s((int)blockIdx.x));
#ifndef NO_GEMM
    if constexpr (ONLY_GEMM < 0 || ONLY_GEMM == ID) pg8::gemm_phase<Epi, pg8::StaticOrder, true, true>(lds, g, S, E, wave);
#endif
}
template <int ID, class Epi> __device__ __forceinline__ void run_gemm(LAS unsigned char* lds, int wave, int gwave, const bf16_t* A, const bf16_t* Bt, int N, int K, const Epi& E, int Mrows = MP) {
    for (int r = 0; r < ((PROBE_GEMM_MASK >> ID) & 1 ? PROBE_GEMM_REP : 1); ++r) run_gemm1<ID>(lds, wave, gwave, A, Bt, N, K, E, Mrows);
}

namespace att {
__device__ __forceinline__ float pair_sum_(float v, int lane) { return v + shx(v, 32, lane); }
typedef float f32x16 __attribute__((ext_vector_type(16)));
typedef short s16x4 __attribute__((ext_vector_type(4)));
typedef short v4i16_t __attribute__((ext_vector_type(4)));
typedef LAS const char* lds_cptr;
typedef LAS char* lds_ptr;
#define MFMA32(a, b, c) __builtin_amdgcn_mfma_f32_32x32x16_bf16((a), (b), (c), 0, 0, 0)
__device__ __forceinline__ int crow(int r, int hi) { return (r & 3) + 8 * (r >> 2) + 4 * hi; }
__device__ __forceinline__ s16x4 vtr(lds_cptr p) { return __builtin_bit_cast(s16x4, __builtin_amdgcn_ds_read_tr16_b64_v4i16((LAS v4i16_t*)p)); }
__device__ __forceinline__ bf16x8 pack8(const f32x16& p, int s) {
    u32x4 w; w.x = cvt_pk_bf16(p[8 * s], p[8 * s + 1]); w.y = cvt_pk_bf16(p[8 * s + 2], p[8 * s + 3]); w.z = cvt_pk_bf16(p[8 * s + 4], p[8 * s + 5]); w.w = cvt_pk_bf16(p[8 * s + 6], p[8 * s + 7]);
    return __builtin_bit_cast(bf16x8, w); }

template <int DK, int DV> struct Geo {
    static constexpr int NPK = DK / 8, NPV = DV / 8, KPS = 1024, VPS = 1088, KBYTES = NPK * KPS, VBYTES = NPV * VPS, NSLOT = 3;
};
template <int DK, int DV>
__device__ __forceinline__ void qk_tile(lds_cptr Kb, const bf16x8 (&qf)[DK / 16], int r32, int hi, f32x16& p0, f32x16& p1) {
    typedef Geo<DK, DV> G;
    f32x16 z;
#pragma unroll
    for (int i = 0; i < 16; ++i) z[i] = 0.f;
#pragma unroll
    for (int ds = 0; ds < DK / 16; ++ds) {
        const bf16x8 a0 = *(const LAS bf16x8*)(Kb + (2 * ds + hi) * G::KPS + r32 * 16);
        const bf16x8 a1 = *(const LAS bf16x8*)(Kb + (2 * ds + hi) * G::KPS + (32 + r32) * 16);
        if (ds == 0) { p0 = MFMA32(a0, qf[0], z); p1 = MFMA32(a1, qf[0], z); } else { p0 = MFMA32(a0, qf[ds], p0); p1 = MFMA32(a1, qf[ds], p1); }
    }
}
template <int DV, bool NEGM>
__device__ __forceinline__ void max_rescale(f32x16& p0, f32x16& p1, float& m, float& l, f32x16 (&o)[DV / 32], f32x16& negm, int lane, bool first) {
    float ra = fmaxf(fmaxf(p0[0], p0[1]), p1[0]), rb = fmaxf(fmaxf(p0[2], p0[3]), p1[1]); ra = fmaxf(fmaxf(ra, p1[2]), p1[3]);
#pragma unroll
    for (int i = 4; i < 16; i += 4) { ra = fmaxf(fmaxf(ra, p0[i]), p0[i + 1]); rb = fmaxf(fmaxf(rb, p0[i + 2]), p0[i + 3]); ra = fmaxf(fmaxf(ra, p1[i]), p1[i + 1]); rb = fmaxf(fmaxf(rb, p1[i + 2]), p1[i + 3]); }
    float rm = fmaxf(ra, rb);
    rm = fmaxf(rm, shx(rm, 32, lane));
    if (NEGM) {
        if (first || __builtin_amdgcn_ballot_w64(rm > 8.0f) != 0ull) {
            const float dl = first ? rm : fmaxf(rm, 0.f), alpha = first ? 1.0f : __builtin_amdgcn_exp2f(-dl); m += dl; l *= alpha;
#pragma unroll
            for (int i = 0; i < 16; ++i) { p0[i] -= dl; p1[i] -= dl; negm[i] = -m; }
#pragma unroll
            for (int d0 = 0; d0 < DV / 32; ++d0)
#pragma unroll
                for (int i = 0; i < 16; ++i) o[d0][i] *= alpha;
        }
    } else {
        if (__builtin_amdgcn_ballot_w64(rm > m + 8.0f) != 0ull) {
            const float mn = fmaxf(m, rm), alpha = __builtin_amdgcn_exp2f(m - mn); m = mn; l *= alpha;
#pragma unroll
            for (int d0 = 0; d0 < DV / 32; ++d0)
#pragma unroll
                for (int i = 0; i < 16; ++i) o[d0][i] *= alpha;
        }
    }
}
template <int DK, int DV, bool NEXT, bool NEGM>
__device__ __forceinline__ void fused_step(lds_cptr Kn, lds_cptr Vc, const bf16x8 (&qf)[DK / 16], bf16x8 ka0, bf16x8 ka1, const f32x16& cinit, f32x16& c0, f32x16& c1, f32x16& n0, f32x16& n1, float m, float& l, f32x16 (&o)[DV / 32],
                                           int r32, int hi, int q4, int p4, int blk) {
    typedef Geo<DK, DV> G;
    constexpr int NDS = DK / 16, ND0 = DV / 32;
    const lds_cptr kp = Kn + hi * G::KPS + r32 * 16;
    const lds_cptr vp = Vc + (2 * blk + (p4 >> 1)) * G::VPS + (4 * hi + q4) * 16 + 8 * (p4 & 1);
    bf16x8 ka[2][2]; ka[0][0] = ka0; ka[0][1] = ka1;
    s16x4 vlo[2][ND0], vhi[2][ND0];
#pragma unroll
    for (int ds = 0; ds < NDS; ++ds) {
        if (NEXT && ds + 1 < NDS) { ka[(ds + 1) & 1][0] = *(const LAS bf16x8*)(kp + (ds + 1) * 2 * G::KPS); ka[(ds + 1) & 1][1] = *(const LAS bf16x8*)(kp + (ds + 1) * 2 * G::KPS + 512); }
        if (ds == NDS - 1) {
#pragma unroll
            for (int d0 = 0; d0 < ND0; ++d0) { vlo[0][d0] = vtr(vp + d0 * 4 * G::VPS); vhi[0][d0] = vtr(vp + d0 * 4 * G::VPS + 128); }
        }
        if (NEXT) { if (ds == 0) { n0 = MFMA32(ka[0][0], qf[0], cinit); n1 = MFMA32(ka[0][1], qf[0], cinit); } else { n0 = MFMA32(ka[ds & 1][0], qf[ds], n0); n1 = MFMA32(ka[ds & 1][1], qf[ds], n1); } }
#pragma unroll
        for (int e = (ds * 32) / NDS; e < ((ds + 1) * 32) / NDS; ++e) { if (e < 16) c0[e] = __builtin_amdgcn_exp2f(NEGM ? c0[e] : c0[e] - m); else c1[e - 16] = __builtin_amdgcn_exp2f(NEGM ? c1[e - 16] : c1[e - 16] - m); }
        __builtin_amdgcn_sched_barrier(0);
    }
    float ls = 0.f;
#pragma unroll
    for (int c = 0; c < 4; ++c) {
        if (c + 1 < 4) {
#pragma unroll
            for (int d0 = 0; d0 < ND0; ++d0) { vlo[(c + 1) & 1][d0] = vtr(vp + d0 * 4 * G::VPS + (c + 1) * 256); vhi[(c + 1) & 1][d0] = vtr(vp + d0 * 4 * G::VPS + (c + 1) * 256 + 128); }
        }
        const f32x16& cc = (c >> 1) == 0 ? c0 : c1; const int s = c & 1;
        const bf16x8 pk = pack8(cc, s);
        ls += ((cc[8 * s] + cc[8 * s + 1]) + (cc[8 * s + 2] + cc[8 * s + 3])) + ((cc[8 * s + 4] + cc[8 * s + 5]) + (cc[8 * s + 6] + cc[8 * s + 7]));
#pragma unroll
        for (int d0 = 0; d0 < ND0; ++d0) {
            const bf16x8 vf = __builtin_shufflevector(vlo[c & 1][d0], vhi[c & 1][d0], 0, 1, 2, 3, 4, 5, 6, 7);
            o[d0] = MFMA32(vf, pk, o[d0]);
        }
        __builtin_amdgcn_sched_barrier(0);
    }
    l += ls;
}
template <int DK, int DV>
__device__ __forceinline__ void attn_pass(lds_ptr lds, int wave, const bf16_t* Q, int qpitch, int qrow, const bf16_t* __restrict__ K, int kpitch, const bf16_t* __restrict__ V, int vpitch,
                                          int xrow0, int ntiles, int qlim_meta, int qs, int wave_last_s, f32x16 (&o)[DV / 32], float& linv) {
    typedef Geo<DK, DV> G;
    const int tid = fresh_tid(wave), lane = tid & 63, r32 = lane & 31, hi = lane >> 5;
    bf16x8 qf[DK / 16];
#pragma unroll
    for (int ds = 0; ds < DK / 16; ++ds) qf[ds] = *(const bf16x8*)(Q + (size_t)qrow * qpitch + 16 * ds + 8 * hi);
    constexpr bool NEGM = (DK == 96);
    float m = NEGM ? 0.f : -1e30f, l = 0.f;
    f32x16 negm;
#pragma unroll
    for (int i = 0; i < 16; ++i) negm[i] = 0.f;
#pragma unroll
    for (int d0 = 0; d0 < DV / 32; ++d0)
#pragma unroll
        for (int i = 0; i < 16; ++i) o[d0][i] = 0.f;
    const lds_ptr KB0 = lds, VB0 = lds + G::NSLOT * G::KBYTES;
    const int wv = launder_s(wave);
    constexpr int NKW = (G::NPK + 7) / 8, NVW = (G::NPV + 7) / 8;
    const int nkw = (wv + 8 * (NKW - 1) < G::NPK) ? NKW : NKW - 1, nvw = (wv + 8 * (NVW - 1) < G::NPV) ? NVW : NVW - 1;
#define ATT_GROW(t) ((t) == 0 ? (size_t)M0 : (size_t)xrow0 + 64 * ((t) - 1))
#define ATT_DMAK(t, slot) do { const bf16_t* src_ = K + (ATT_GROW(t) + lane) * kpitch; \
        _Pragma("unroll") for (int i = 0; i < NKW; ++i) { const int c_ = wv + 8 * i; if (c_ < G::NPK) \
            __builtin_amdgcn_global_load_lds((const unsigned*)(src_ + c_ * 8), (LAS unsigned*)(KB0 + (slot) * G::KBYTES + c_ * G::KPS), 16, 0, 0); } } while (0)
#define ATT_DMAV(t, slot) do { const bf16_t* src_ = V + (ATT_GROW(t) + lane) * vpitch; \
        _Pragma("unroll") for (int i = 0; i < NVW; ++i) { const int c_ = wv + 8 * i; if (c_ < G::NPV) \
            __builtin_amdgcn_global_load_lds((const unsigned*)(src_ + c_ * 8), (LAS unsigned*)(VB0 + (slot) * G::VBYTES + c_ * G::VPS), 16, 0, 0); } } while (0)
#define ATT_WAIT_BAR(n) do { const int n_ = (n); \
        if (n_ == 0) asm volatile("s_waitcnt vmcnt(0) lgkmcnt(0)" ::: "memory"); else if (n_ == 1) asm volatile("s_waitcnt vmcnt(1) lgkmcnt(0)" ::: "memory"); \
        else if (n_ == 2) asm volatile("s_waitcnt vmcnt(2) lgkmcnt(0)" ::: "memory"); else if (n_ == 3) asm volatile("s_waitcnt vmcnt(3) lgkmcnt(0)" ::: "memory"); \
        else asm volatile("s_waitcnt vmcnt(4) lgkmcnt(0)" ::: "memory"); \
        __builtin_amdgcn_s_barrier(); asm volatile("" ::: "memory"); } while (0)
#define ATT_ACTIVE(j) ((j) == 0 || 64 * ((j) - 1) <= wave_last_s)
#define ATT_NEEDMASK(j) ((j) == 0 || 64 * ((j) - 1) + 63 > wave_last_s - 31)
    asm volatile("s_waitcnt vmcnt(0)" ::: "memory");
    ATT_DMAK(0, 0); ATT_DMAV(0, 0); if (ntiles > 1) ATT_DMAK(1, 1);
    int late = 0;
    if (ntiles > 1) { ATT_DMAV(1, 1); late += nvw; }
    if (ntiles > 2) { ATT_DMAK(2, 2); late += nkw; }
    ATT_WAIT_BAR(late);
    const int q4 = (lane & 15) >> 2, p4 = lane & 3, blk = (lane >> 4) & 1;
    f32x16 pA0, pA1, pB0, pB1;
    qk_tile<DK, DV>(KB0, qf, r32, hi, pA0, pA1);
    asm volatile("s_waitcnt lgkmcnt(0)" ::: "memory"); __builtin_amdgcn_s_barrier(); asm volatile("" ::: "memory");
    int sk1 = 1, sv0 = 0;
#define ATT_STEP(C0, C1, N0, N1, J) do { const int j_ = (J); int issued_ = 0; \
        if (j_ + 3 < ntiles) { ATT_DMAK(j_ + 3, sk1 == 0 ? 2 : sk1 - 1); issued_ += nkw; } \
        if (j_ + 2 < ntiles) { ATT_DMAV(j_ + 2, sv0 == 0 ? 2 : sv0 - 1); issued_ += nvw; } \
        const lds_cptr Kn_ = KB0 + sk1 * G::KBYTES; const lds_cptr Vc_ = VB0 + sv0 * G::VBYTES; \
        if (j_ < ntiles && ATT_ACTIVE(j_)) { \
              \
            const bf16x8 ka0_ = *(const LAS bf16x8*)(Kn_ + hi * G::KPS + r32 * 16), ka1_ = *(const LAS bf16x8*)(Kn_ + hi * G::KPS + (32 + r32) * 16); \
            if (ATT_NEEDMASK(j_)) { const int kvbase = (j_ == 0) ? 0 : 64 * (j_ - 1); const int qlim = (j_ == 0) ? qlim_meta : qs; \
                _Pragma("unroll") for (int i = 0; i < 16; ++i) { const int kv = kvbase + crow(i, hi); if (kv > qlim) C0[i] = -1e30f; if (kv + 32 > qlim) C1[i] = -1e30f; } } \
            max_rescale<DV, NEGM>(C0, C1, m, l, o, negm, lane, j_ == 0); \
            fused_step<DK, DV, true, NEGM>(Kn_, Vc_, qf, ka0_, ka1_, negm, C0, C1, N0, N1, m, l, o, r32, hi, q4, p4, blk); \
        } \
        sk1 = sk1 == 2 ? 0 : sk1 + 1; sv0 = sv0 == 2 ? 0 : sv0 + 1; \
        ATT_WAIT_BAR(issued_); } while (0)
    for (int j = 0; j < ntiles; j += 2) { ATT_STEP(pA0, pA1, pB0, pB1, j); ATT_STEP(pB0, pB1, pA0, pA1, j + 1); }
    asm volatile("s_waitcnt vmcnt(0)" ::: "memory");
#undef ATT_STEP
#undef ATT_GROW
#undef ATT_DMAK
#undef ATT_DMAV
#undef ATT_WAIT_BAR
#undef ATT_ACTIVE
#undef ATT_NEEDMASK
    l += shx(l, 32, lane);
    linv = 1.0f / l;
}

constexpr int LDS_NEED = 3 * ((Geo<64, 128>::KBYTES + Geo<64, 128>::VBYTES) > (Geo<96, 64>::KBYTES + Geo<96, 64>::VBYTES) ? (Geo<64, 128>::KBYTES + Geo<64, 128>::VBYTES) : (Geo<96, 64>::KBYTES + Geo<96, 64>::VBYTES));

struct Tensors { const bf16_t *QA, *KA, *VA, *QD, *KD, *VD; bf16_t *AOA, *AOB; const float* subln; float lam, lam_init; float* o1scr; };

__device__ __forceinline__ void mla_unit(lds_ptr lds, int wave, const Tensors& T, int b, int h, int qb, bool isx) {
    const int tid = fresh_tid(wave), lane = tid & 63, r32 = lane & 31, hi = lane >> 5, w = wave;
    int qrow, qs, qlim_meta, wave_last_s, ntiles, xrow0 = b * SEQ;
    if (isx) { qs = 256 * qb + 32 * w + r32; qrow = xrow0 + qs; qlim_meta = 15; wave_last_s = 256 * qb + 32 * w + 31; ntiles = 1 + 4 * (qb + 1); }
    else { qs = -1; qrow = M0 + 32 * w + r32; qlim_meta = r32 < 15 ? r32 : 15; wave_last_s = -1; ntiles = 1; if (w > 0) qlim_meta = 15; }
    f32x16 o[2]; float linv;
    attn_pass<96, 64>(lds, wave, T.QA + h * 96, 768, qrow, T.KA + h * 96, 768, T.VA + h * 64, 512, xrow0, ntiles, qlim_meta, qs, wave_last_s, o, linv);
    bf16_t* dst = T.AOA + (size_t)qrow * 512 + h * 64 + 4 * hi;
#pragma unroll
    for (int d0 = 0; d0 < 2; ++d0)
#pragma unroll
        for (int g = 0; g < 4; ++g) {
            uint2 wv; wv.x = cvt_pk_bf16(o[d0][4 * g] * linv, o[d0][4 * g + 1] * linv); wv.y = cvt_pk_bf16(o[d0][4 * g + 2] * linv, o[d0][4 * g + 3] * linv);
            *(uint2*)(dst + 32 * d0 + 8 * g) = wv; }
}
__device__ __forceinline__ void mla_unit64(lds_ptr lds, int wave, const Tensors& T, int b, int h, int qb8) {
    typedef Geo<96, 64> G; constexpr int NDS = 6, ND0 = 2;
    const int tid = fresh_tid(wave), lane = tid & 63, r32 = lane & 31, hi = lane >> 5;
    const int wv = launder_s(wave);
    const int xrow0 = b * SEQ, slab = 512 * qb8 + 64 * wv, sA = slab + r32, sB = sA + 32;
    const int ntiles = 1 + 8 * (qb8 + 1), last_active = 8 * qb8 + wv + 1;
    const bf16_t* Q = T.QA + h * 96; const bf16_t* __restrict__ K = T.KA + h * 96; const bf16_t* __restrict__ V = T.VA + h * 64;
    constexpr int kpitch = 768, vpitch = 512;
    bf16x8 qA[NDS], qB[NDS];
#pragma unroll
    for (int ds = 0; ds < NDS; ++ds) { qA[ds] = *(const bf16x8*)(Q + (size_t)(xrow0 + sA) * 768 + 16 * ds + 8 * hi); qB[ds] = *(const bf16x8*)(Q + (size_t)(xrow0 + sB) * 768 + 16 * ds + 8 * hi); }
    float mA = -1e30f, mB = -1e30f, lA = 0.f, lB = 0.f;
    f32x16 oA[ND0], oB[ND0], nz;
#pragma unroll
    for (int i = 0; i < 16; ++i) { oA[0][i] = 0.f; oA[1][i] = 0.f; oB[0][i] = 0.f; oB[1][i] = 0.f; nz[i] = 0.f; }
    const lds_ptr KB0 = lds, VB0 = lds + G::NSLOT * G::KBYTES;
    constexpr int NKW = (G::NPK + 7) / 8, NVW = (G::NPV + 7) / 8;
    const int nkw = (wv + 8 * (NKW - 1) < G::NPK) ? NKW : NKW - 1, nvw = (wv + 8 * (NVW - 1) < G::NPV) ? NVW : NVW - 1;
#define U64_GROW(t) ((t) == 0 ? (size_t)M0 : (size_t)xrow0 + 64 * ((t) - 1))
#define U64_DMAK(t, slot) do { const bf16_t* src_ = K + (U64_GROW(t) + lane) * kpitch; \
        _Pragma("unroll") for (int i = 0; i < NKW; ++i) { const int c_ = wv + 8 * i; if (c_ < G::NPK) \
            __builtin_amdgcn_global_load_lds((const unsigned*)(src_ + c_ * 8), (LAS unsigned*)(KB0 + (slot) * G::KBYTES + c_ * G::KPS), 16, 0, 0); } } while (0)
#define U64_DMAV(t, slot) do { const bf16_t* src_ = V + (U64_GROW(t) + lane) * vpitch; \
        _Pragma("unroll") for (int i = 0; i < NVW; ++i) { const int c_ = wv + 8 * i; if (c_ < G::NPV) \
            __builtin_amdgcn_global_load_lds((const unsigned*)(src_ + c_ * 8), (LAS unsigned*)(VB0 + (slot) * G::VBYTES + c_ * G::VPS), 16, 0, 0); } } while (0)
#define U64_WAIT_BAR(n) do { const int n_ = (n); \
        if (n_ == 0) asm volatile("s_waitcnt vmcnt(0) lgkmcnt(0)" ::: "memory"); else if (n_ == 1) asm volatile("s_waitcnt vmcnt(1) lgkmcnt(0)" ::: "memory"); \
        else if (n_ == 2) asm volatile("s_waitcnt vmcnt(2) lgkmcnt(0)" ::: "memory"); else if (n_ == 3) asm volatile("s_waitcnt vmcnt(3) lgkmcnt(0)" ::: "memory"); \
        else asm volatile("s_waitcnt vmcnt(4) lgkmcnt(0)" ::: "memory"); \
        __builtin_amdgcn_s_barrier(); asm volatile("" ::: "memory"); } while (0)
    asm volatile("s_waitcnt vmcnt(0)" ::: "memory");
    U64_DMAK(0, 0); U64_DMAV(0, 0);
    U64_DMAK(1, 1); U64_DMAV(1, 1);
    U64_WAIT_BAR(nkw + nvw);
    const int q4 = (lane & 15) >> 2, p4 = lane & 3, blk = (lane >> 4) & 1;
    int sk = 0;
    for (int j = 0; j < ntiles; ++j) {
        int issued = 0;
        if (j + 2 < ntiles) { const int s2 = sk == 0 ? 2 : sk - 1; U64_DMAK(j + 2, s2); U64_DMAV(j + 2, s2); issued = nkw + nvw; }
        if (j <= last_active) {
            const lds_cptr kp = KB0 + sk * G::KBYTES + hi * G::KPS + r32 * 16;
            const lds_cptr vp = VB0 + sk * G::VBYTES + (2 * blk + (p4 >> 1)) * G::VPS + (4 * hi + q4) * 16 + 8 * (p4 & 1);
            f32x16 a0, a1, b0, b1;
            bf16x8 ka[2][2]; ka[0][0] = *(const LAS bf16x8*)(kp); ka[0][1] = *(const LAS bf16x8*)(kp + 512);
#pragma unroll
            for (int ds = 0; ds < NDS; ++ds) {
                if (ds + 1 < NDS) { ka[(ds + 1) & 1][0] = *(const LAS bf16x8*)(kp + (ds + 1) * 2 * G::KPS); ka[(ds + 1) & 1][1] = *(const LAS bf16x8*)(kp + (ds + 1) * 2 * G::KPS + 512); }
                if (ds == 0) { a0 = MFMA32(ka[0][0], qA[0], nz); a1 = MFMA32(ka[0][1], qA[0], nz); b0 = MFMA32(ka[0][0], qB[0], nz); b1 = MFMA32(ka[0][1], qB[0], nz); }
                else { a0 = MFMA32(ka[ds & 1][0], qA[ds], a0); a1 = MFMA32(ka[ds & 1][1], qA[ds], a1); b0 = MFMA32(ka[ds & 1][0], qB[ds], b0); b1 = MFMA32(ka[ds & 1][1], qB[ds], b1); }
                __builtin_amdgcn_sched_barrier(0);
            }
            if (j == 0 || j == last_active) { const int kvbase = (j == 0) ? 0 : 64 * (j - 1); const int limA = (j == 0) ? 15 : sA, limB = (j == 0) ? 15 : sB;
#pragma unroll
                for (int i = 0; i < 16; ++i) { const int kv = kvbase + crow(i, hi);
                    if (kv > limA) a0[i] = -1e30f; if (kv + 32 > limA) a1[i] = -1e30f; if (kv > limB) b0[i] = -1e30f; if (kv + 32 > limB) b1[i] = -1e30f; } }
            max_rescale<64, false>(a0, a1, mA, lA, oA, nz, lane, false);
            max_rescale<64, false>(b0, b1, mB, lB, oB, nz, lane, false);
            s16x4 vlo[2][ND0], vhi[2][ND0];
#pragma unroll
            for (int d0 = 0; d0 < ND0; ++d0) { vlo[0][d0] = vtr(vp + d0 * 4 * G::VPS); vhi[0][d0] = vtr(vp + d0 * 4 * G::VPS + 128); }
#pragma unroll
            for (int i = 0; i < 16; ++i) { a0[i] = __builtin_amdgcn_exp2f(a0[i] - mA); a1[i] = __builtin_amdgcn_exp2f(a1[i] - mA); b0[i] = __builtin_amdgcn_exp2f(b0[i] - mB); b1[i] = __builtin_amdgcn_exp2f(b1[i] - mB); }
            __builtin_amdgcn_sched_barrier(0);
            float lsA = 0.f, lsB = 0.f;
#pragma unroll
            for (int c = 0; c < 4; ++c) {
                if (c + 1 < 4) {
#pragma unroll
                    for (int d0 = 0; d0 < ND0; ++d0) { vlo[(c + 1) & 1][d0] = vtr(vp + d0 * 4 * G::VPS + (c + 1) * 256); vhi[(c + 1) & 1][d0] = vtr(vp + d0 * 4 * G::VPS + (c + 1) * 256 + 128); }
                }
                const f32x16& ca = (c >> 1) == 0 ? a0 : a1; const f32x16& cb = (c >> 1) == 0 ? b0 : b1; const int s = c & 1;
                const bf16x8 pkA = pack8(ca, s), pkB = pack8(cb, s);
                lsA += ((ca[8 * s] + ca[8 * s + 1]) + (ca[8 * s + 2] + ca[8 * s + 3])) + ((ca[8 * s + 4] + ca[8 * s + 5]) + (ca[8 * s + 6] + ca[8 * s + 7]));
                lsB += ((cb[8 * s] + cb[8 * s + 1]) + (cb[8 * s + 2] + cb[8 * s + 3])) + ((cb[8 * s + 4] + cb[8 * s + 5]) + (cb[8 * s + 6] + cb[8 * s + 7]));
#pragma unroll
                for (int d0 = 0; d0 < ND0; ++d0) {
                    const bf16x8 vf = __builtin_shufflevector(vlo[c & 1][d0], vhi[c & 1][d0], 0, 1, 2, 3, 4, 5, 6, 7);
                    oA[d0] = MFMA32(vf, pkA, oA[d0]); oB[d0] = MFMA32(vf, pkB, oB[d0]);
                }
                __builtin_amdgcn_sched_barrier(0);
            }
            lA += lsA; lB += lsB;
        }
        sk = sk == 2 ? 0 : sk + 1;
        U64_WAIT_BAR(issued);
    }
    asm volatile("s_waitcnt vmcnt(0)" ::: "memory");
#undef U64_GROW
#undef U64_DMAK
#undef U64_DMAV
#undef U64_WAIT_BAR
    const float liA = 1.0f / pair_sum_(lA, lane), liB = 1.0f / pair_sum_(lB, lane);
    bf16_t* dA = T.AOA + (size_t)(xrow0 + sA) * 512 + h * 64 + 4 * hi; bf16_t* dB = T.AOA + (size_t)(xrow0 + sB) * 512 + h * 64 + 4 * hi;
#pragma unroll
    for (int d0 = 0; d0 < 2; ++d0)
#pragma unroll
        for (int g = 0; g < 4; ++g) {
            uint2 wa; wa.x = cvt_pk_bf16(oA[d0][4 * g] * liA, oA[d0][4 * g + 1] * liA); wa.y = cvt_pk_bf16(oA[d0][4 * g + 2] * liA, oA[d0][4 * g + 3] * liA);
            uint2 wb; wb.x = cvt_pk_bf16(oB[d0][4 * g] * liB, oB[d0][4 * g + 1] * liB); wb.y = cvt_pk_bf16(oB[d0][4 * g + 2] * liB, oB[d0][4 * g + 3] * liB);
            *(uint2*)(dA + 32 * d0 + 8 * g) = wa; *(uint2*)(dB + 32 * d0 + 8 * g) = wb; }
}
__device__ __forceinline__ void diff_unit(lds_ptr lds, int wave, const Tensors& T, int b, int h, int qb, bool isx) {
    const int tid = fresh_tid(wave), lane = tid & 63, r32 = lane & 31, hi = lane >> 5, w = wave;
    int qrow, qs, qlim_meta, wave_last_s, ntiles, xrow0 = b * SEQ;
    if (isx) { qs = 256 * qb + 32 * w + r32; qrow = xrow0 + qs; qlim_meta = 15; wave_last_s = 256 * qb + 32 * w + 31; ntiles = 1 + 4 * (qb + 1); }
    else { qs = -1; qrow = M0 + 32 * w + r32; qlim_meta = r32 < 15 ? r32 : 15; wave_last_s = -1; ntiles = 1; if (w > 0) qlim_meta = 15; }
    f32x16 o2[4]; float linv2;
    f32x4* sp = (f32x4*)(T.o1scr) + tid;
    {
        f32x16 o1[4]; float linv1;
        attn_pass<64, 128>(lds, wave, T.QD + (2 * h) * 64, 512, qrow, T.KD + (2 * h) * 64, 512, T.VD + h * 128, 512, xrow0, ntiles, qlim_meta, qs, wave_last_s, o1, linv1);
#pragma unroll
        for (int d0 = 0; d0 < 4; ++d0)
#pragma unroll
            for (int g = 0; g < 4; ++g) sp[(d0 * 4 + g) * 512] = (f32x4){o1[d0][4 * g] * linv1, o1[d0][4 * g + 1] * linv1, o1[d0][4 * g + 2] * linv1, o1[d0][4 * g + 3] * linv1};
    }
    attn_pass<64, 128>(lds, wave, T.QD + (2 * h + 1) * 64, 512, qrow, T.KD + (2 * h + 1) * 64, 512, T.VD + h * 128, 512, xrow0, ntiles, qlim_meta, qs, wave_last_s, o2, linv2);
    const float lam2 = T.lam * linv2; float ss = 0.f;
    f32x16 o1[4];
#pragma unroll
    for (int d0 = 0; d0 < 4; ++d0)
#pragma unroll
        for (int g = 0; g < 4; ++g) { const f32x4 t = sp[(d0 * 4 + g) * 512]; o1[d0][4 * g] = t[0]; o1[d0][4 * g + 1] = t[1]; o1[d0][4 * g + 2] = t[2]; o1[d0][4 * g + 3] = t[3]; }
#pragma unroll
    for (int d0 = 0; d0 < 4; ++d0)
#pragma unroll
        for (int i = 0; i < 16; ++i) { const float d = o1[d0][i] - lam2 * o2[d0][i]; o1[d0][i] = d; ss += d * d; }
    ss += shx(ss, 32, lane);
    const float rs = rsqrtf(ss * (1.0f / 128.0f) + EPS) * (1.0f - T.lam_init);
    bf16_t* dst = T.AOB + (size_t)qrow * 512 + h * 128 + 4 * hi;
#pragma unroll
    for (int d0 = 0; d0 < 4; ++d0)
#pragma unroll
        for (int g = 0; g < 4; ++g) { const f32x4 sg = *(const f32x4*)(T.subln + 32 * d0 + 8 * g + 4 * hi);
            uint2 wv; wv.x = cvt_pk_bf16(o1[d0][4 * g] * rs * sg[0], o1[d0][4 * g + 1] * rs * sg[1]); wv.y = cvt_pk_bf16(o1[d0][4 * g + 2] * rs * sg[2], o1[d0][4 * g + 3] * rs * sg[3]);
            *(uint2*)(dst + 32 * d0 + 8 * g) = wv; }
}
__device__ __forceinline__ void attn_phase(lds_ptr lds, int wave, const Tensors& T, int vcu_, int G_) {
    const int vcu = launder_s(vcu_), G = launder_s(G_);
    for (int v = vcu; v < 256; v += G) {
        { const int bh = v >> 3, s = v & 7;
#ifndef NO_DIFF
          diff_unit(lds, wave, T, bh >> 2, bh & 3, s, true); diff_unit(lds, wave, T, bh >> 2, bh & 3, 15 - s, true);
#endif
        }
        { const int bh = v >> 2, s = v & 3;
#ifndef NO_MLA
          mla_unit64(lds, wave, T, bh >> 3, bh & 7, s); mla_unit64(lds, wave, T, bh >> 3, bh & 7, 7 - s);
#endif
        }
#ifndef NO_MLA
        if (v < 8) mla_unit(lds, wave, T, 0, v, 0, false);
#endif
#ifndef NO_DIFF
        if (v >= 8 && v < 12) diff_unit(lds, wave, T, 0, v - 8, 0, false);
#endif
    }
}
}

#define XB_TMO      128
#define XB_XCNT(j)  (256  + 64 * (j))
#define XB_XSUB(j)  (1280 + 64 * (j))
#define XB_XGEN(j)  (2304 + 64 * (j))
#define XB_TOP      3328
#define XB_TOPGEN   3392
#define XCD_BAR_WORDS 3456
#define XB_SPIN_CAP (1u << 18)

__device__ __forceinline__ unsigned xb_ld(unsigned* p)              { return __hip_atomic_load(p, __ATOMIC_RELAXED, __HIP_MEMORY_SCOPE_AGENT); }
__device__ __forceinline__ unsigned xb_add(unsigned* p, unsigned v) { return __hip_atomic_fetch_add(p, v, __ATOMIC_RELAXED, __HIP_MEMORY_SCOPE_AGENT); }
__device__ __forceinline__ unsigned xb_xcc_id() { return (unsigned)__builtin_amdgcn_s_getreg((3 << 11) | 20) & 0xFu; }
#define XB_SPIN(cond, bar) do { unsigned _sp = 0; while (cond) { __builtin_amdgcn_s_sleep(1); \
    if ((++_sp & 255u) == 0u) { if (xb_ld(&(bar)[XB_TMO])) break; if (_sp > XB_SPIN_CAP) { atomicAdd(&(bar)[XB_TMO], 1u); break; } } } } while (0)

struct XcdBarrier { unsigned* bar; unsigned x; volatile LAS unsigned* st; };
__device__ __forceinline__ XcdBarrier xcd_barrier_post(unsigned* bar, volatile LAS unsigned* st, int tid) {
    XcdBarrier b; b.bar = bar; b.x = xb_xcc_id(); b.st = st;
    if (tid == 0) (void)xb_add(&bar[XB_XCNT(b.x)], 1u);
    return b;
}
__device__ __forceinline__ void xcd_barrier_complete(unsigned* bar, unsigned x, unsigned& nloc, unsigned& nx) {
    const unsigned G = gridDim.x * gridDim.y * gridDim.z;
    unsigned sum, cnt, mine, sp = 0u;
    for (;;) {
        sum = 0u; cnt = 0u; mine = 0u;
#pragma unroll
        for (unsigned j = 0; j < 16; ++j) { const unsigned c = xb_ld(&bar[XB_XCNT(j)]); sum += c; cnt += (c > 0u) ? 1u : 0u; mine = (j == x) ? c : mine; }
        if (sum == G) break;
        __builtin_amdgcn_s_sleep(1);
        if ((++sp & 255u) == 0u) { if (xb_ld(&bar[XB_TMO])) break; if (sp > XB_SPIN_CAP) { atomicAdd(&bar[XB_TMO], 1u); break; } }
    }
    nloc = mine > 0u ? mine : 1u; nx = cnt > 0u ? cnt : 1u;
}

__device__ __forceinline__ void xcd_barrier(const XcdBarrier& b, int tid) {
    asm volatile("s_waitcnt vmcnt(0)" ::: "memory");
    __syncthreads();
    if (tid == 0) {
        unsigned* bar = b.bar;
        __builtin_amdgcn_s_waitcnt(0);
        unsigned nloc = b.st[0], nx = b.st[1];
        if (nloc == 0u) { xcd_barrier_complete(bar, b.x, nloc, nx); b.st[0] = nloc; b.st[1] = nx; }
        const unsigned old = xb_add(&bar[XB_XSUB(b.x)], 1u);
        const unsigned gen = old / nloc;
        if (old + 1u == (gen + 1u) * nloc) {
            __builtin_amdgcn_fence(__ATOMIC_RELEASE, "agent");
            asm volatile("s_waitcnt vmcnt(0)" ::: "memory");
            const unsigned og = xb_add(&bar[XB_TOP], 1u);
            const unsigned tg = og / nx;
            if (og + 1u == (tg + 1u) * nx) xb_add(&bar[XB_TOPGEN], 1u);
            else XB_SPIN(xb_ld(&bar[XB_TOPGEN]) == tg, bar);
            __builtin_amdgcn_fence(__ATOMIC_ACQUIRE, "agent");
            xb_add(&bar[XB_XGEN(b.x)], 1u);
            asm volatile("s_waitcnt vmcnt(0)" ::: "memory");
        } else {
            XB_SPIN(xb_ld(&bar[XB_XGEN(b.x)]) == gen, bar);
            __builtin_amdgcn_fence(__ATOMIC_ACQUIRE, "agent");
            asm volatile("s_waitcnt vmcnt(0)" ::: "memory");
        }
    }
    __syncthreads();
}

enum { WK_ID = 0, WK_INA, WK_INB, WK_UQ, WK_UKV, WK_GU };
__device__ __forceinline__ int src_col(int kind, int n) {
    switch (kind) {
    case WK_INA: {
        if (n < 1024) { const int seg = n >> 9, g = (n & 511) >> 6, j = n & 63; const int t = j < 16 ? ((j & 1) ? 8 + (j >> 1) : (j >> 1)) : j; return (seg == 0 ? 672 : 1184) + 64 * g + t; }
        if (n < 1536) return 1696 + (n - 1024);
        if (n < 1792) return 384 + (n - 1536);
        if (n < 2176) return n - 1792;
        if (n < 2208) { const int j = n - 2176; return 640 + ((j & 1) ? 16 + (j >> 1) : (j >> 1)); }
        return -1; }
    case WK_INB: return 2208 + n;
    case WK_UQ: { const int hd = n / 96, j = n % 96; if (j < 64) return n; const int jj = j - 64; return hd * 96 + 64 + ((jj & 1) ? 16 + (jj >> 1) : (jj >> 1)); }
    case WK_UKV: { if (n < 512) return (n >> 6) * 128 + (n & 63); const int nn = n - 512; return (nn >> 6) * 128 + 64 + (nn & 63); }
    case WK_GU: { const int t = n >> 8, c = n & 255; return c < 128 ? 128 * t + c : DFF + 128 * t + (c - 128); }
    default: return n;
    }
}
__device__ __forceinline__ void transpose_item(const float* __restrict__ W, int K, int N, const float* __restrict__ gain, bf16_t* WT, int kind, LAS float* scr, int item, int lane) {
    const int kblk = K / 64, nb = item / kblk, kb = item % kblk, k0 = 64 * kb, n0 = 32 * nb;
    const int s0 = src_col(kind, n0), base = s0 & ~31;
    f32x4 v[8];
    const int c4 = lane & 7, kr = lane >> 3;
    if (s0 >= 0) {
#pragma unroll
        for (int i = 0; i < 8; ++i) v[i] = __builtin_nontemporal_load((const f32x4*)(W + (size_t)(k0 + kr + 8 * i) * N + base + 4 * c4));
        if (gain) {
#pragma unroll
            for (int i = 0; i < 8; ++i) v[i] = v[i] * gain[k0 + kr + 8 * i];
        }
    } else {
#pragma unroll
        for (int i = 0; i < 8; ++i) v[i] = (f32x4){0.f, 0.f, 0.f, 0.f};
    }
#pragma unroll
    for (int i = 0; i < 8; ++i) { LAS float* d = scr + (kr + 8 * i) * 33 + 4 * c4; d[0] = v[i][0]; d[1] = v[i][1]; d[2] = v[i][2]; d[3] = v[i][3]; }
    asm volatile("s_waitcnt lgkmcnt(0)" ::: "memory");
    const int c = lane & 7;
#pragma unroll
    for (int j = 0; j < 4; ++j) { const int n = (lane >> 3) + 8 * j; const int sc = s0 >= 0 ? src_col(kind, n0 + n) - base : n; const LAS float* s = scr + (8 * c) * 33 + sc;
        u32x4 o; o.x = pk2(s[0 * 33], s[1 * 33]); o.y = pk2(s[2 * 33], s[3 * 33]); o.z = pk2(s[4 * 33], s[5 * 33]); o.w = pk2(s[6 * 33], s[7 * 33]);
        *(u32x4*)(WT + (size_t)(n0 + n) * K + k0 + 8 * c) = o; }
    asm volatile("s_waitcnt lgkmcnt(0)" ::: "memory");
}
struct WDesc { int in_idx, K, N, Np, kind, gain_idx; size_t off; };
__device__ __forceinline__ WDesc wdesc(int i) {
    switch (i) {
    case 0: return WDesc{I_WIN, 1024, 4256, 2304, WK_INA, -1, WO_INA};
    case 1: return WDesc{I_WIN, 1024, 4256, 2048, WK_INB, -1, WO_INB};
    case 2: return WDesc{I_WUQ, 384, 768, 768, WK_UQ, I_QNORM, WO_UQ};
    case 3: return WDesc{I_WUKV, 256, 1024, 1024, WK_UKV, I_KVNORM, WO_UKV};
    case 4: return WDesc{I_WOMLA, 512, 1024, 1024, WK_ID, -1, WO_OMLA};
    case 5: return WDesc{I_WODIFF, 512, 1024, 1024, WK_ID, -1, WO_ODIFF};
    case 6: return WDesc{I_WOUT, 1024, 1024, 1024, WK_ID, -1, WO_OUT};
    case 7: return WDesc{I_WGU, 1024, 5632, 5632, WK_GU, -1, WO_GU};
    default: return WDesc{I_WDOWN, 2816, 1024, 1024, WK_ID, -1, WO_DOWN};
    }
}
__device__ __forceinline__ void wave_sum4(float (&s)[4], int lane) {
#pragma unroll
    for (int o = 1; o < 64; o <<= 1) {
        float t[4];
#pragma unroll
        for (int r = 0; r < 4; ++r) t[r] = shx(s[r], o, lane);
#pragma unroll
        for (int r = 0; r < 4; ++r) s[r] += t[r];
    }
}
__device__ __forceinline__ void row_pass(int gw_, int ngw_, int wave_, int nrows, const float* rin_x, const float* rin_m, const bf16_t* mix, const float* gpost, const bf16_t* mix2, const float* gpost2, float* rout_x, float* rout_m, const float* gnext, bf16_t* XN) {
    const int lane = fresh_tid(wave_) & 63; const int gw = launder_s(gw_), ngw = launder_s(ngw_);
    static_assert(M0 % 4 == 0 && MVALID % 4 == 0 && MP % 4 == 0, "row groups of 4 never straddle a buffer boundary");
    for (int g = gw; g < nrows / 4; g += ngw) {
        const int row0 = 4 * g;
        if (row0 >= MVALID) { if (XN) {
#pragma unroll
                for (int r = 0; r < 4; ++r) { unsigned long long* o8 = (unsigned long long*)(XN + (size_t)(row0 + r) * DM) + lane;
#pragma unroll
                    for (int j = 0; j < 4; ++j) o8[64 * j] = 0ull; } } continue; }
        const float* rp = row0 < M0 ? rin_x + (size_t)row0 * DM : rin_m + (size_t)(row0 - M0) * DM;
        f32x4 v[4][4];
#pragma unroll
        for (int r = 0; r < 4; ++r)
#pragma unroll
            for (int j = 0; j < 4; ++j) v[r][j] = __builtin_nontemporal_load((const f32x4*)(rp + (size_t)r * DM) + lane + 64 * j);
        if (mix) {
            uint2 mw[4][4];
#pragma unroll
            for (int r = 0; r < 4; ++r)
#pragma unroll
                for (int j = 0; j < 4; ++j) { typedef unsigned u32x2_ __attribute__((ext_vector_type(2))); const u32x2_ t_ = __builtin_nontemporal_load((const u32x2_*)(mix + (size_t)(row0 + r) * DM) + lane + 64 * j); mw[r][j].x = t_.x; mw[r][j].y = t_.y; }
            f32x4 gp[4];
#pragma unroll
            for (int j = 0; j < 4; ++j) gp[j] = ((const f32x4*)gpost)[lane + 64 * j];
            float s[4];
#pragma unroll
            for (int r = 0; r < 4; ++r) { s[r] = 0.f;
#pragma unroll
                for (int j = 0; j < 4; ++j) { const f32x4 m4 = (f32x4){bflo(mw[r][j].x), bfhi(mw[r][j].x), bflo(mw[r][j].y), bfhi(mw[r][j].y)}; s[r] += sumsq4(m4); } }
            wave_sum4(s, lane);
#pragma unroll
            for (int r = 0; r < 4; ++r) { const float rs = rsqrtf(s[r] * (1.0f / DM) + EPS);
#pragma unroll
                for (int j = 0; j < 4; ++j) { const f32x4 m4 = (f32x4){bflo(mw[r][j].x), bfhi(mw[r][j].x), bflo(mw[r][j].y), bfhi(mw[r][j].y)}; v[r][j] = v[r][j] + m4 * rs * gp[j]; } }
        }
        if (mix2) {
            uint2 mw[4][4];
#pragma unroll
            for (int r = 0; r < 4; ++r)
#pragma unroll
                for (int j = 0; j < 4; ++j) { typedef unsigned u32x2_ __attribute__((ext_vector_type(2))); const u32x2_ t_ = __builtin_nontemporal_load((const u32x2_*)(mix2 + (size_t)(row0 + r) * DM) + lane + 64 * j); mw[r][j].x = t_.x; mw[r][j].y = t_.y; }
            f32x4 gp[4];
#pragma unroll
            for (int j = 0; j < 4; ++j) gp[j] = ((const f32x4*)gpost2)[lane + 64 * j];
            float s[4];
#pragma unroll
            for (int r = 0; r < 4; ++r) { s[r] = 0.f;
#pragma unroll
                for (int j = 0; j < 4; ++j) { const f32x4 m4 = (f32x4){bflo(mw[r][j].x), bfhi(mw[r][j].x), bflo(mw[r][j].y), bfhi(mw[r][j].y)}; s[r] += sumsq4(m4); } }
            wave_sum4(s, lane);
#pragma unroll
            for (int r = 0; r < 4; ++r) { const float rs = rsqrtf(s[r] * (1.0f / DM) + EPS);
#pragma unroll
                for (int j = 0; j < 4; ++j) { const f32x4 m4 = (f32x4){bflo(mw[r][j].x), bfhi(mw[r][j].x), bflo(mw[r][j].y), bfhi(mw[r][j].y)}; v[r][j] = v[r][j] + m4 * rs * gp[j]; } }
        }
        if (rout_x) { float* op = row0 < M0 ? rout_x + (size_t)row0 * DM : rout_m + (size_t)(row0 - M0) * DM;
#pragma unroll
            for (int r = 0; r < 4; ++r)
#pragma unroll
                for (int j = 0; j < 4; ++j) __builtin_nontemporal_store(v[r][j], (f32x4*)(op + (size_t)r * DM) + lane + 64 * j); }
        if (XN) { float s[4];
#pragma unroll
            for (int r = 0; r < 4; ++r) { s[r] = 0.f;
#pragma unroll
                for (int j = 0; j < 4; ++j) s[r] += sumsq4(v[r][j]); }
            wave_sum4(s, lane);
            f32x4 gn[4];
#pragma unroll
            for (int j = 0; j < 4; ++j) gn[j] = ((const f32x4*)gnext)[lane + 64 * j];
#pragma unroll
            for (int r = 0; r < 4; ++r) { const float rs = rsqrtf(s[r] * (1.0f / DM) + EPS); unsigned long long* o8 = (unsigned long long*)(XN + (size_t)(row0 + r) * DM) + lane;
#pragma unroll
                for (int j = 0; j < 4; ++j) { const f32x4 y = v[r][j] * rs * gn[j];
                    o8[64 * j] = (unsigned long long)cvt_pk_bf16(y[0], y[1]) | ((unsigned long long)cvt_pk_bf16(y[2], y[3]) << 32); } } }
    }
}

constexpr int LDS_BYTES = 131072 + 1024;
static_assert(att::LDS_NEED <= 131072, "attention LDS");
__global__ void __launch_bounds__(512, 2) fwd_megakernel(Params p) {
    extern __shared__ __attribute__((aligned(16))) unsigned char lds_raw[];
    LAS unsigned char* lds = (LAS unsigned char*)lds_raw;
    cg::grid_group grid = cg::this_grid();
    const int wave = __builtin_amdgcn_readfirstlane((int)threadIdx.x >> 6);
    const int G = gridDim.x, bx = blockIdx.x, vcu = (G % 8 == 0) ? (bx % 8) * (G / 8) + bx / 8 : bx;
    const int gw = vcu * 8 + wave, ngw = G * 8;
    { const int t0 = fresh_tid(wave); if (t0 < 64) ((LAS unsigned*)(lds + 131072))[t0] = 0u; __syncthreads(); }
    const XcdBarrier xbar = xcd_barrier_post((unsigned*)(p.ws + WS_BAR), (volatile LAS unsigned*)(lds + 131072 + 32), fresh_tid(wave));
#define GRID_BAR() xcd_barrier(xbar, fresh_tid(wave))
#define WSP() ({ unsigned char* w__ = p.ws; asm volatile("" : "+s"(w__)); w__; })
#define B16(w, off) ((bf16_t*)((w) + (off)))
    {
        unsigned char* ws = WSP();
        float* lamp = (float*)(ws + WS_LAM); float* rope = (float*)(ws + WS_ROPE);
        LAS float* scr = (LAS float*)(lds + wave * 16384);
        const int tid = fresh_tid(wave), lane = tid & 63;
        for (int L = 0; L < NLAYER; ++L)
            for (int wi = 0; wi < 9; ++wi) {
                const WDesc d = wdesc(wi);
                const float* W = p.in[d.in_idx] + (size_t)L * d.K * d.N;
                const float* gain = d.gain_idx >= 0 ? p.in[d.gain_idx] + (size_t)L * d.K : nullptr;
                bf16_t* WT = (bf16_t*)(ws + WS_W + L * WS_WSTRIDE + d.off);
                const int nitems = (d.Np / 32) * (d.K / 64);
                for (int it = gw; it < nitems; it += ngw) transpose_item(W, d.K, d.N, gain, WT, d.kind, scr, it, lane);
            }
        for (int i = bx * 512 + tid; i < NPOS * 24; i += G * 512) { const int pos = i / 24, f = i % 24; const double rev = (double)pos * p.invrev[f]; const float fr = (float)(rev - floor(rev));
            rope[2 * i] = __builtin_amdgcn_cosf(fr); rope[2 * i + 1] = __builtin_amdgcn_sinf(fr); }
        if (launder_s(bx) == 0 && launder_s(wave) == 0) {
            for (int L = 0; L < NLAYER; ++L) { const float* lp = p.in[I_LAMBDA] + L * 256;
                const float a = wave_sum(lp[lane] * lp[64 + lane], lane), b = wave_sum(lp[128 + lane] * lp[192 + lane], lane);
                const float lam_init = L == 0 ? 0.2f : 0.35550906759096924f;
                if (lane == 0) lamp[L] = expf(a) - expf(b) + lam_init; }
        }
        row_pass(gw, ngw, wave, MP, p.in[I_X], p.in[I_META], nullptr, nullptr, nullptr, nullptr, nullptr, nullptr, p.in[I_NMIXPRE], B16(ws, WS_XN));
    }
    grid.sync();

    for (int L = 0; L < NLAYER; ++L) {
        const size_t wlo = WS_W + L * WS_WSTRIDE;
        const size_t sqo = WS_SSQQ, skvo = WS_SSQKV;
        const int Mpost = (L + 1 < NLAYER) ? MP : M0;
        { unsigned char* ws = WSP();
          EpiInA E{B16(ws, WS_QD), B16(ws, WS_KD), B16(ws, WS_VD), B16(ws, WS_KVL), B16(ws, WS_QL), B16(ws, WS_KA), (float*)(ws + sqo), (float*)(ws + skvo), (const float*)(ws + WS_ROPE)};
          run_gemm<0>(lds, wave, gw, B16(ws, WS_XN), B16(ws, wlo + WO_INA), 2304, 1024, E); }
        GRID_BAR();
        { unsigned char* ws = WSP(); EpiQA E{B16(ws, WS_QA), (const float*)(ws + sqo), (const float*)(ws + WS_ROPE)}; run_gemm<1>(lds, wave, gw, B16(ws, WS_QL), B16(ws, wlo + WO_UQ), 768, 384, E); }
        { unsigned char* ws = WSP(); EpiKV E{B16(ws, WS_KA), B16(ws, WS_VA), (const float*)(ws + skvo)}; run_gemm<2>(lds, wave, gw, B16(ws, WS_KVL), B16(ws, wlo + WO_UKV), 1024, 256, E); }
        GRID_BAR();
        { unsigned char* ws = WSP();
          att::Tensors T{B16(ws, WS_QA), B16(ws, WS_KA), B16(ws, WS_VA), B16(ws, WS_QD), B16(ws, WS_KD), B16(ws, WS_VD), B16(ws, WS_AOA), B16(ws, WS_AOB), p.in[I_SUBLN] + L * 128, ((const float*)(ws + WS_LAM))[L], L == 0 ? 0.2f : 0.35550906759096924f, (float*)(ws + WS_O1 + (size_t)bx * 131072)};
          att::attn_phase((att::lds_ptr)lds, wave, T, vcu, G);
#ifdef PROBE_ATT2
          att::attn_phase((att::lds_ptr)lds, wave, T, vcu, G);
#endif
        }
        GRID_BAR();
        if (Mpost == MP) {
            { unsigned char* ws = WSP(); EpiGate E{B16(ws, WS_G), 0}; mini_gemm(lds, wave, B16(ws, WS_XN), B16(ws, wlo + WO_INB), 1024, 1024, E); }
            { unsigned char* ws = WSP(); EpiGate E{B16(ws, WS_G), 1024}; mini_gemm(lds, wave, B16(ws, WS_XN), B16(ws, wlo + WO_INB) + (size_t)1024 * 1024, 1024, 1024, E); }
            { unsigned char* ws = WSP(); EpiMix<false> E{B16(ws, WS_MIXIN), B16(ws, WS_G), 0}; mini_gemm(lds, wave, B16(ws, WS_AOA), B16(ws, wlo + WO_OMLA), 1024, 512, E); }
            { unsigned char* ws = WSP(); EpiMix<true> E{B16(ws, WS_MIXIN), B16(ws, WS_G), 1024}; mini_gemm(lds, wave, B16(ws, WS_AOB), B16(ws, wlo + WO_ODIFF), 1024, 512, E); }
        }
        { unsigned char* ws = WSP(); EpiGate E{B16(ws, WS_G), 0}; run_gemm_pair(lds, wave, B16(ws, WS_XN), B16(ws, wlo + WO_INB), 1024, E, 0); }
        { unsigned char* ws = WSP(); EpiMixPair E{B16(ws, WS_MIXIN), B16(ws, WS_G)}; run_gemm_pair(lds, wave, B16(ws, WS_AOA), B16(ws, wlo + WO_OMLA), 512, E, AO_PM_OFF); }
        GRID_BAR();
        { unsigned char* ws = WSP(); EpiPlain E{B16(ws, WS_MIX), 1024}; run_gemm<7>(lds, wave, gw, B16(ws, WS_MIXIN), B16(ws, wlo + WO_OUT), 1024, 1024, E, Mpost); }
        GRID_BAR();
        { unsigned char* ws = WSP(); float* RM = (float*)(ws + WS_RM);
          row_pass(gw, ngw, wave, Mpost, L == 0 ? p.in[I_X] : p.out, L == 0 ? p.in[I_META] : RM, B16(ws, WS_MIX), p.in[I_NMIXPOST] + L * DM, nullptr, nullptr, nullptr, nullptr, p.in[I_NFFNPRE] + L * DM, B16(ws, WS_XN)); }
        GRID_BAR();
        { unsigned char* ws = WSP(); EpiSwiglu E{B16(ws, WS_FF)}; run_gemm<8>(lds, wave, gw, B16(ws, WS_XN), B16(ws, wlo + WO_GU), 5632, 1024, E, Mpost); }
        GRID_BAR();
        { unsigned char* ws = WSP(); EpiPlain E{B16(ws, WS_FFO), 1024}; run_gemm<9>(lds, wave, gw, B16(ws, WS_FF), B16(ws, wlo + WO_DOWN), 1024, DFF, E, Mpost); }
        GRID_BAR();
        { unsigned char* ws = WSP(); float* RM = (float*)(ws + WS_RM);
          const float* r0x = L == 0 ? p.in[I_X] : p.out; const float* r0m = L == 0 ? p.in[I_META] : RM;
          if (L + 1 < NLAYER) row_pass(gw, ngw, wave, MP, r0x, r0m, B16(ws, WS_MIX), p.in[I_NMIXPOST] + L * DM, B16(ws, WS_FFO), p.in[I_NFFNPOST] + L * DM, p.out, RM, p.in[I_NMIXPRE] + (L + 1) * DM, B16(ws, WS_XN));
          else row_pass(gw, ngw, wave, M0, r0x, r0m, B16(ws, WS_MIX), p.in[I_NMIXPOST] + L * DM, B16(ws, WS_FFO), p.in[I_NFFNPOST] + L * DM, p.out, RM, nullptr, nullptr); }
        if (L + 1 < NLAYER) GRID_BAR();
    }
}

extern "C" void kernel_launch(void* const* d_in, const int* in_sizes, int n_in, void* d_out, int out_size, void* d_ws, size_t ws_size, hipStream_t stream) {
    static int grid = 0;
    if (grid == 0) {
        if (n_in != 18 || ws_size < WS_END) { fprintf(stderr, "kernel_launch: unexpected n_in %d / ws_size %zu\n", n_in, ws_size); grid = -1; return; }
        int dev = 0, cus = 0, per_cu = 0;
        hipGetDevice(&dev); hipDeviceGetAttribute(&cus, hipDeviceAttributeMultiprocessorCount, dev);
        if (hipFuncSetAttribute((const void*)fwd_megakernel, hipFuncAttributeMaxDynamicSharedMemorySize, LDS_BYTES) != hipSuccess) { fprintf(stderr, "kernel_launch: hipFuncSetAttribute failed\n"); grid = -1; return; }
        if (hipOccupancyMaxActiveBlocksPerMultiprocessor(&per_cu, (const void*)fwd_megakernel, 512, LDS_BYTES) != hipSuccess || per_cu < 1) { fprintf(stderr, "kernel_launch: occupancy query gave %d\n", per_cu); per_cu = 1; }
        (void)hipGetLastError();
        grid = cus < 256 ? cus : 256;
    }
    if (grid < 0) return;
    Params p{};
    for (int i = 0; i < 18; ++i) p.in[i] = (const float*)d_in[i];
    p.out = (float*)d_out; p.ws = (unsigned char*)d_ws;
    const double TWO_PI = 6.283185307179586476925286766559;
    for (int i = 0; i < 16; ++i) p.invrev[i] = pow(500000.0, -(double)i / 16.0) / TWO_PI;
    for (int i = 0; i < 8; ++i) p.invrev[16 + i] = pow(500000.0, -(double)i / 8.0) / TWO_PI;
    if (hipMemsetAsync((char*)d_ws + WS_BAR, 0, WS_BAR_BYTES, stream) != hipSuccess) { fprintf(stderr, "kernel_launch: memset failed\n"); return; }
    void* args[] = {&p};
    hipError_t e = hipLaunchCooperativeKernel((const void*)fwd_megakernel, dim3(grid), dim3(512), args, LDS_BYTES, stream);
    if (e != hipSuccess) fprintf(stderr, "cooperative launch failed: %s (grid %d)\n", hipGetErrorString(e), grid);
}
```
